# Optimizing an MI355X kernel written in HIP

```python
import jax, jax.numpy as jnp
from jax import lax
import numpy as np

D_MODEL = 2048
BATCH = 8
SEQ = 2048
DEPTH = 2

HEAD_DIM = 128
MLA_HEADS = 8
SB_HEADS = 4
DSA_HEADS = 4
N_MIX_HEADS = MLA_HEADS + SB_HEADS + DSA_HEADS
MIX_WIDTH = N_MIX_HEADS * HEAD_DIM
Q_LORA = 512
KV_LORA = 256
MLA_NOPE = 128
MLA_ROPE = 64
MLA_V = HEAD_DIM
IDX_HEADS = 16
IDX_DIM = 64
IDX_SCALE = (IDX_HEADS * IDX_DIM) ** -0.5
TOPK_MAX = 256
Q_BLOCK = 128
ROPE_THETA = 10000.0
MAX_POS_OFFSET = 4096
N_EXPERTS = 64
TOP_K = 8
N_GROUPS = 8
TOPK_GROUPS = 4
D_EXPERT = 512
D_SHARED = 512
ROUTED_SCALE = 2.5
MOE_BLOCK = 128
EPS = 1e-6

IN_SIZES = (Q_LORA, KV_LORA, MLA_ROPE,
            SB_HEADS * HEAD_DIM, SB_HEADS * HEAD_DIM, SB_HEADS * HEAD_DIM,
            DSA_HEADS * HEAD_DIM, HEAD_DIM, HEAD_DIM,
            IDX_HEADS * IDX_DIM, IDX_DIM, IDX_HEADS)
IN_WIDTH = int(sum(IN_SIZES))
IN_OFFSETS = tuple(int(o) for o in np.cumsum(IN_SIZES)[:-1])

kernel_name = "hybrid_mla_stickbreak_dsa_moe_adaln"


def rms_norm(x, g):
    xf = x.astype(jnp.float32)
    y = xf * lax.rsqrt(jnp.mean(xf * xf, axis=-1, keepdims=True) + EPS)
    return (y * g.astype(jnp.float32)).astype(x.dtype)


def rope(x, positions):
    d = x.shape[-1]
    inv_freq = ROPE_THETA ** (-jnp.arange(0, d, 2, dtype=jnp.float32) / d)
    ang = positions.astype(jnp.float32)[:, :, None, None] * inv_freq
    cos, sin = jnp.cos(ang), jnp.sin(ang)
    x1, x2 = jnp.split(x.astype(jnp.float32), 2, axis=-1)
    return jnp.concatenate([x1 * cos - x2 * sin, x2 * cos + x1 * sin], axis=-1).astype(x.dtype)


def over_query_blocks(fn, *qs):
    B, S = qs[0].shape[:2]
    nb = S // Q_BLOCK
    blocks = tuple(jnp.swapaxes(q.reshape(B, nb, Q_BLOCK, *q.shape[2:]), 0, 1) for q in qs)
    out = lax.map(lambda args: fn(*args), (jnp.arange(nb), *blocks))
    return jnp.swapaxes(out, 0, 1).reshape(B, S, *out.shape[3:])


def causal_softmax_attention(q, k, v, scale):
    key_pos = jnp.arange(k.shape[1])

    def block(i, qb):
        qpos = i * Q_BLOCK + jnp.arange(Q_BLOCK)
        s = jnp.einsum('bqhd,bkhd->bhqk', qb, k, preferred_element_type=jnp.float32) * scale
        s = jnp.where(key_pos[None, :] <= qpos[:, None], s, -jnp.inf)
        p = jax.nn.softmax(s, axis=-1).astype(v.dtype)
        return jnp.einsum('bhqk,bkhd->bqhd', p, v)

    return over_query_blocks(block, q)


def stick_breaking_attention(q, k, v):
    key_pos = jnp.arange(k.shape[1])
    scale = q.shape[-1] ** -0.5

    def block(i, qb):
        qpos = i * Q_BLOCK + jnp.arange(Q_BLOCK)
        z = jnp.einsum('bqhd,bkhd->bhqk', qb, k, preferred_element_type=jnp.float32) * scale
        strict = key_pos[None, :] < qpos[:, None]
        log_keep = jnp.where(strict, jax.nn.log_sigmoid(-z), 0.0)
        log_w = jax.nn.log_sigmoid(z) + lax.cumsum(log_keep, axis=3, reverse=True) - log_keep
        a = jnp.where(strict, jnp.exp(log_w), 0.0).astype(v.dtype)
        return jnp.einsum('bhqk,bkhd->bqhd', a, v)

    return over_query_blocks(block, q)


def dsa_attention(q, k, v, q_idx, k_idx, w_idx):
    S = k.shape[1]
    n_sel = min(TOPK_MAX, S // 4)
    key_pos = jnp.arange(S)
    scale = q.shape[-1] ** -0.5
    gather = jax.vmap(lambda t, idx: t[idx])

    def block(i, qb, qib, wb):
        qpos = i * Q_BLOCK + jnp.arange(Q_BLOCK)
        rel = jax.nn.relu(jnp.einsum('bqhe,bke->bqhk', qib, k_idx, preferred_element_type=jnp.float32))
        score = jnp.einsum('bqh,bqhk->bqk', wb.astype(jnp.float32), rel) * IDX_SCALE
        score = jnp.where(key_pos[None, None, :] <= qpos[None, :, None], score, -jnp.inf)
        _, sel = lax.top_k(score, n_sel)
        valid = sel <= qpos[None, :, None]
        kg = gather(k, sel)
        vg = gather(v, sel)
        s = jnp.einsum('bqhd,bqnd->bhqn', qb, kg, preferred_element_type=jnp.float32) * scale
        s = jnp.where(valid[:, None], s, -jnp.inf)
        p = jax.nn.softmax(s, axis=-1).astype(vg.dtype)
        return jnp.einsum('bhqn,bqnd->bqhd', p, vg)

    return over_query_blocks(block, q, q_idx, w_idx)


def token_mixers(h, positions, w_in, g_cq, g_ckv, w_uq, w_ukv, g_out, w_o):
    B, S, _ = h.shape
    proj = h @ w_in
    (cq, ckv, kr, sb_q, sb_k, sb_v, ds_q, ds_k, ds_v, ix_q, ix_k, ix_w) = jnp.split(proj, IN_OFFSETS, axis=-1)

    q = (rms_norm(cq, g_cq) @ w_uq).reshape(B, S, MLA_HEADS, MLA_NOPE + MLA_ROPE)
    kv = (rms_norm(ckv, g_ckv) @ w_ukv).reshape(B, S, MLA_HEADS, MLA_NOPE + MLA_V)
    k_rope = jnp.broadcast_to(rope(kr[:, :, None, :], positions), (B, S, MLA_HEADS, MLA_ROPE))
    q_mla = jnp.concatenate([q[..., :MLA_NOPE], rope(q[..., MLA_NOPE:], positions)], axis=-1)
    k_mla = jnp.concatenate([kv[..., :MLA_NOPE], k_rope], axis=-1)
    o_mla = causal_softmax_attention(q_mla, k_mla, kv[..., MLA_NOPE:], (MLA_NOPE + MLA_ROPE) ** -0.5)

    heads = lambda t: t.reshape(B, S, SB_HEADS, HEAD_DIM)
    o_sb = stick_breaking_attention(heads(sb_q), heads(sb_k), heads(sb_v))

    q_c = rope(ds_q.reshape(B, S, DSA_HEADS, HEAD_DIM), positions)
    k_c = rope(ds_k[:, :, None, :], positions)[:, :, 0, :]
    q_ix = rope(ix_q.reshape(B, S, IDX_HEADS, IDX_DIM), positions)
    k_ix = rope(ix_k[:, :, None, :], positions)[:, :, 0, :]
    o_dsa = dsa_attention(q_c, k_c, ds_v, q_ix, k_ix, ix_w)

    o = jnp.concatenate([o_mla, o_sb, o_dsa], axis=2)
    o = rms_norm(o, g_out.reshape(N_MIX_HEADS, HEAD_DIM)).reshape(B, S, MIX_WIDTH)
    return o @ w_o


def swiglu(x, w_gate, w_up, w_down):
    return (jax.nn.silu(x @ w_gate) * (x @ w_up)) @ w_down


def moe_ffn(h, w_router, b_router, w_gate, w_up, w_down, ws_gate, ws_up, ws_down):
    B, S, D = h.shape
    T = B * S
    xt = h.reshape(T, D)
    scores = jax.nn.sigmoid((xt @ w_router).astype(jnp.float32))
    biased = scores + b_router.astype(jnp.float32)
    grp = lax.top_k(biased.reshape(T, N_GROUPS, N_EXPERTS // N_GROUPS), 2)[0].sum(-1)
    _, gsel = lax.top_k(grp, TOPK_GROUPS)
    gmask = jnp.any(gsel[:, :, None] == jnp.arange(N_GROUPS), axis=1)
    emask = jnp.repeat(gmask, N_EXPERTS // N_GROUPS, axis=1)
    _, eidx = lax.top_k(jnp.where(emask, biased, -jnp.inf), TOP_K)
    gate = jnp.take_along_axis(scores, eidx, axis=1)
    gate = gate / jnp.sum(gate, axis=-1, keepdims=True) * ROUTED_SCALE

    M = T * TOP_K
    e_flat = eidx.reshape(M)
    tok_flat = jnp.repeat(jnp.arange(T, dtype=jnp.int32), TOP_K)
    order = jnp.argsort(e_flat, stable=True)
    e_s, tok_s, g_s = e_flat[order], tok_flat[order], gate.reshape(M)[order]
    counts = jnp.bincount(e_flat, length=N_EXPERTS)
    padded = (counts + MOE_BLOCK - 1) // MOE_BLOCK * MOE_BLOCK
    start = jnp.cumsum(counts) - counts
    pend = jnp.cumsum(padded)
    pstart = pend - padded
    dest = pstart[e_s] + (jnp.arange(M) - start[e_s])
    n_blocks = -(-M // MOE_BLOCK) + N_EXPERTS
    P = n_blocks * MOE_BLOCK
    tok_buf = jnp.full((P,), T, jnp.int32).at[dest].set(tok_s)
    g_buf = jnp.zeros((P,), jnp.float32).at[dest].set(g_s)
    blk_exp = jnp.minimum(jnp.searchsorted(pend, jnp.arange(n_blocks) * MOE_BLOCK, side='right'), N_EXPERTS - 1)
    x_pad = jnp.concatenate([xt, jnp.zeros((1, D), xt.dtype)], axis=0)

    def step(acc, blk):
        tok_b, g_b, e_b = blk
        yb = swiglu(x_pad[tok_b], w_gate[e_b], w_up[e_b], w_down[e_b])
        return acc.at[tok_b].add((yb * g_b[:, None].astype(yb.dtype)).astype(acc.dtype)), None

    acc, _ = lax.scan(step, jnp.zeros((T + 1, D), xt.dtype),
                      (tok_buf.reshape(n_blocks, MOE_BLOCK), g_buf.reshape(n_blocks, MOE_BLOCK), blk_exp))
    out = acc[:T] + swiglu(xt, ws_gate, ws_up, ws_down)
    return out.reshape(B, S, D)


def setup_inputs(seed: int = 0) -> dict:
    key = jax.random.key(seed)
    ks = iter(jax.random.split(key, 32))
    nrm = lambda shape, scale: jax.random.normal(next(ks), shape, jnp.float32) * scale
    gain = lambda shape: 1.0 + nrm(shape, 0.02)
    L = DEPTH
    return {
        "x": nrm((BATCH, SEQ, D_MODEL), 1.0),
        "c": nrm((BATCH, D_MODEL), 1.0),
        "positions": (jax.random.randint(next(ks), (BATCH, 1), 0, MAX_POS_OFFSET) + jnp.arange(SEQ)[None, :]).astype(jnp.int32),
        "norm_mix_g": gain((L, D_MODEL)),
        "norm_ffn_g": gain((L, D_MODEL)),
        "w_ada": nrm((L, D_MODEL, 6 * D_MODEL), 0.5 * D_MODEL ** -0.5),
        "b_ada": nrm((L, 6 * D_MODEL), 0.02),
        "w_in": nrm((L, D_MODEL, IN_WIDTH), D_MODEL ** -0.5),
        "g_cq": gain((L, Q_LORA)),
        "g_ckv": gain((L, KV_LORA)),
        "w_uq": nrm((L, Q_LORA, MLA_HEADS * (MLA_NOPE + MLA_ROPE)), Q_LORA ** -0.5),
        "w_ukv": nrm((L, KV_LORA, MLA_HEADS * (MLA_NOPE + MLA_V)), KV_LORA ** -0.5),
        "g_out": gain((L, MIX_WIDTH)),
        "w_o": nrm((L, MIX_WIDTH, D_MODEL), MIX_WIDTH ** -0.5),
        "w_router": nrm((L, D_MODEL, N_EXPERTS), D_MODEL ** -0.5),
        "b_router": nrm((L, N_EXPERTS), 0.01),
        "w_gate": nrm((L, N_EXPERTS, D_MODEL, D_EXPERT), D_MODEL ** -0.5),
        "w_up": nrm((L, N_EXPERTS, D_MODEL, D_EXPERT), D_MODEL ** -0.5),
        "w_down": nrm((L, N_EXPERTS, D_EXPERT, D_MODEL), D_EXPERT ** -0.5),
        "ws_gate": nrm((L, D_MODEL, D_SHARED), D_MODEL ** -0.5),
        "ws_up": nrm((L, D_MODEL, D_SHARED), D_MODEL ** -0.5),
        "ws_down": nrm((L, D_SHARED, D_MODEL), D_SHARED ** -0.5),
        "final_g": gain((D_MODEL,)),
    }


def reference(x, c, positions, norm_mix_g, norm_ffn_g, w_ada, b_ada, w_in, g_cq, g_ckv, w_uq, w_ukv,
              g_out, w_o, w_router, b_router, w_gate, w_up, w_down, ws_gate, ws_up, ws_down, final_g):
    for l in range(DEPTH):
        mod = (jax.nn.silu(c) @ w_ada[l] + b_ada[l])[:, None, :]
        sh_m, sc_m, g_m, sh_f, sc_f, g_f = jnp.split(mod, 6, axis=-1)
        h = rms_norm(x, norm_mix_g[l]) * (1 + sc_m) + sh_m
        x = x + g_m * token_mixers(h, positions, w_in[l], g_cq[l], g_ckv[l], w_uq[l], w_ukv[l], g_out[l], w_o[l])
        h = rms_norm(x, norm_ffn_g[l]) * (1 + sc_f) + sh_f
        x = x + g_f * moe_ffn(h, w_router[l], b_router[l], w_gate[l], w_up[l], w_down[l],
                              ws_gate[l], ws_up[l], ws_down[l])
    return rms_norm(x, final_g)
```

```cpp
#ifndef MK_FUSED
#define MK_FUSED 1
#endif
#ifndef WIN_FP8
#define WIN_FP8 1
#endif
#ifndef SH_FP8
#define SH_FP8 1
#endif
#ifndef QUOTA_R
#define QUOTA_R 0
#endif
#ifndef STAGGER_SLEEP
#define STAGGER_SLEEP 0
#endif
#ifndef DEFER_STORE
#define DEFER_STORE 0
#endif
#ifndef UQ_FP8
#define UQ_FP8 0
#endif
#ifndef WO_FP8
#define WO_FP8 1
#endif
#include <hip/hip_runtime.h>
#include <cstdio>
#include <cstdint>

#define LAS __attribute__((address_space(3)))
typedef unsigned short bf16_t;
typedef short bf16x8 __attribute__((ext_vector_type(8)));
typedef short s16x4 __attribute__((ext_vector_type(4)));
typedef float f32x2 __attribute__((ext_vector_type(2)));
typedef float f32x4 __attribute__((ext_vector_type(4)));
typedef float f32x16 __attribute__((ext_vector_type(16)));
typedef unsigned u32x2 __attribute__((ext_vector_type(2)));
typedef unsigned u32x4 __attribute__((ext_vector_type(4)));

constexpr int NB = 8, SEQ = 2048, T = NB * SEQ, DM = 2048, NL = 2;
constexpr int NPROJ = 4352, INW = 4240;
constexpr int O_CQ = 0, O_CKV = 512, O_KR = 768, O_SBQ = 832, O_SBK = 1344, O_SBV = 1856, O_DSQ = 2368, O_DSK = 2880, O_DSV = 3008,
              O_IXQ = 3136, O_IXK = 4160, O_IXW = 4224;
constexpr int NE = 64, TOPK = 8, DE = 512;
constexpr int PMAX = T * TOPK + NE * 256;
constexpr float EPS = 1e-6f;
constexpr int NWAVES = 8, NTHR = 512;
#ifdef SMALL_LDS
constexpr int LDS_BYTES = 32768; constexpr int LDS_MISC = 16384;
#else
constexpr int LDS_BYTES = 147456;
constexpr int LDS_MISC = 140 * 1024;
#endif
constexpr int LDS_TAB = 132 * 1024;

constexpr size_t WS_CTL = 0, CTL_BYTES = 1u << 20;
constexpr size_t WS_MOD = WS_CTL + CTL_BYTES;
constexpr size_t WS_W = WS_MOD + (1u << 20);
constexpr size_t LW_IN = 0;
constexpr size_t LW_UQ = LW_IN + (size_t)NPROJ * DM * 2;
constexpr size_t LW_UKV = LW_UQ + (size_t)1536 * 512 * 2;
constexpr size_t LW_O = LW_UKV + (size_t)2048 * 256 * 2;
constexpr size_t LW_S1 = LW_O + (size_t)DM * DM * 2;
constexpr size_t LW_S2 = LW_S1 + (size_t)1024 * DM * 2;
constexpr size_t LW_R = LW_S2 + (size_t)DM * 512 * 2;
constexpr size_t LW_1 = LW_R + (size_t)64 * DM * 2;
constexpr size_t LW_2 = LW_1 + (size_t)NE * 1024 * DM;
constexpr size_t LW_BYTES = LW_2 + (size_t)NE * DM * 512 * 2;
constexpr size_t WS_ACT = WS_W + NL * LW_BYTES;
constexpr size_t WS_H = WS_ACT;
constexpr size_t WS_CQ8 = WS_ACT;
static_assert(!(UQ_FP8 && (WIN_FP8 != 1 || !SH_FP8)), "WS_CQ8 overlays the bf16 activation buffer");
constexpr size_t WS_H8 = WS_H + (size_t)T * DM * 2;
constexpr size_t WS_X1 = WS_H8 + (size_t)T * DM;
constexpr size_t WS_X2 = WS_X1 + (size_t)T * DM * 4;
constexpr size_t WS_RTE = WS_X2 + (size_t)T * DM * 4;
constexpr size_t WS_RTS = WS_RTE + (size_t)T * 8 * 4;
constexpr size_t WS_RTG = WS_RTS + (size_t)T * 8 * 4;
constexpr size_t WS_ST = WS_RTG + (size_t)T * 8 * 4;
constexpr size_t WS_UN = WS_ST + (size_t)NE * T * 4;
constexpr size_t WS_PROJ = WS_UN;
constexpr size_t WS_Q = WS_PROJ + (size_t)T * NPROJ * 2;
constexpr size_t WS_KV = WS_Q + (size_t)T * 1536 * 2;
constexpr size_t WS_CS = WS_KV + (size_t)T * 2048 * 2;
constexpr size_t WS_SC = WS_CS + (size_t)T * 64 * 4;
constexpr size_t WS_MASK = WS_SC + (size_t)T * SEQ * 4;
constexpr size_t WS_O = WS_MASK + (size_t)T * 32 * 8;
constexpr size_t WS_MIX_END = WS_O + (size_t)T * DM * 2;
constexpr size_t WS_H1 = WS_UN;
constexpr size_t WS_HS = WS_H1 + (size_t)PMAX * 512 * 2;
constexpr size_t WS_Y = WS_HS + (size_t)T * 512 * 2;
constexpr size_t WS_YS = WS_Y + (size_t)PMAX * DM * 2;
constexpr size_t WS_FFN_END = WS_YS + (size_t)T * DM * 2;
static_assert(SH_FP8 == 1, "the combine phase reads the shared-expert output as fp8");
constexpr size_t WS_END = WS_MIX_END > WS_FFN_END ? WS_MIX_END : WS_FFN_END;
static_assert(WS_END <= (size_t)2100 * 1000 * 1000, "workspace must fit 4 x the largest tensor (2.147 GB)");
constexpr float W1_SCALE = 32.f, W2_SCALE = 16.f, Y_SCALE = 16.f;
#ifndef WIN_FP8
#define WIN_FP8 0
#endif
constexpr int WIN_B0 = 12, WIN_NB = 5;
#ifndef SH_FP8
#define SH_FP8 0
#endif
#ifndef WO_FP8
#define WO_FP8 0
#endif
constexpr int CW_CNT = 8192;

#define LDS_WAIT() asm volatile("s_waitcnt lgkmcnt(0)" ::: "memory")
#define VM_WAIT() asm volatile("s_waitcnt vmcnt(0)" ::: "memory")
#define SBAR() __builtin_amdgcn_sched_barrier(0)
__device__ __forceinline__ unsigned cvtpk(float lo, float hi) { unsigned r; asm volatile("v_cvt_pk_bf16_f32 %0, %1, %2" : "=v"(r) : "v"(lo), "v"(hi)); return r; }
__device__ __forceinline__ float bf2f(unsigned short b) { return __uint_as_float(((unsigned)b) << 16); }
__device__ __forceinline__ float bflo(unsigned w) { return __uint_as_float(w << 16); }
__device__ __forceinline__ float bfhi(unsigned w) { return __uint_as_float(w & 0xffff0000u); }
__device__ __forceinline__ unsigned short f2bf(float f) { return (unsigned short)(cvtpk(f, 0.f) & 0xffffu); }
__device__ __forceinline__ unsigned pk4_fp8(float a, float b, float c, float d) { int w = 0; w = __builtin_amdgcn_cvt_pk_fp8_f32(a, b, w, false); w = __builtin_amdgcn_cvt_pk_fp8_f32(c, d, w, true); return (unsigned)w; }
__device__ __forceinline__ float wave_sum(float v) {
    int x = __float_as_int(v);
#define WS_STEP(ctrl, rmask) x = __float_as_int(__int_as_float(x) + __int_as_float(__builtin_amdgcn_update_dpp(0, x, ctrl, rmask, 0xF, true)))
    WS_STEP(0xB1, 0xF);
    WS_STEP(0x4E, 0xF);
    WS_STEP(0x141, 0xF);
    WS_STEP(0x140, 0xF);
    WS_STEP(0x142, 0xA);
    WS_STEP(0x143, 0xC);
#undef WS_STEP
    return __int_as_float(__builtin_amdgcn_readlane(x, 63));
}
__device__ __forceinline__ bf16x8 pack8(f32x4 a, f32x4 b) {
    u32x4 w = {cvtpk(a[0], a[1]), cvtpk(a[2], a[3]), cvtpk(b[0], b[1]), cvtpk(b[2], b[3])};
    return *reinterpret_cast<bf16x8*>(&w);
}

#define XB_TMO      128
#define XB_XCNT(j)  (256  + 64 * (j))
#define XB_XSUB(j)  (1280 + 64 * (j))
#define XB_XGEN(j)  (2304 + 64 * (j))
#define XB_TOP      3328
#define XB_TOPGEN   3392
#define XCD_BAR_WORDS 3456
#define XB_SPIN_CAP (1u << 22)
__device__ __forceinline__ unsigned xb_ld(unsigned* p)              { return __hip_atomic_load(p, __ATOMIC_RELAXED, __HIP_MEMORY_SCOPE_AGENT); }
__device__ __forceinline__ unsigned xb_add(unsigned* p, unsigned v) { return __hip_atomic_fetch_add(p, v, __ATOMIC_RELAXED, __HIP_MEMORY_SCOPE_AGENT); }
__device__ __forceinline__ unsigned xb_xcc_id() { return (unsigned)__builtin_amdgcn_s_getreg((3 << 11) | 20) & 0xFu; }
#define XB_SPIN(cond, bar) do { unsigned _sp = 0; while (cond) { __builtin_amdgcn_s_sleep(1); \
    if ((++_sp & 255u) == 0u) { if (xb_ld(&(bar)[XB_TMO])) break; if (_sp > XB_SPIN_CAP) { atomicAdd(&(bar)[XB_TMO], 1u); break; } } } } while (0)
struct XcdBarrier { unsigned* bar; unsigned x; volatile LAS unsigned* st; };
__device__ __forceinline__ int lane_id() { int l; asm volatile("v_mbcnt_lo_u32_b32 %0, -1, 0\n\tv_mbcnt_hi_u32_b32 %0, -1, %0" : "=&v"(l)); return l; }
__device__ __forceinline__ XcdBarrier xcd_barrier_post(unsigned* bar, volatile LAS unsigned* st, int wave_s) {
    XcdBarrier b; b.bar = bar; b.x = xb_xcc_id(); b.st = st;
    if (wave_s == 0 && lane_id() == 0) (void)xb_add(&bar[XB_XCNT(b.x)], 1u);
    return b;
}
__device__ __forceinline__ void xcd_barrier_complete(unsigned* bar, unsigned x, unsigned& nloc, unsigned& nx) {
    const unsigned G = gridDim.x * gridDim.y * gridDim.z;
    unsigned sum, cnt, mine, sp = 0u;
    for (;;) {
        sum = 0u; cnt = 0u; mine = 0u;
#pragma unroll
        for (unsigned j = 0; j < 16; ++j) { const unsigned c = xb_ld(&bar[XB_XCNT(j)]); sum += c; cnt += (c > 0u) ? 1u : 0u; mine = (j == x) ? c : mine; }
        if (sum == G) break;
        __builtin_amdgcn_s_sleep(1);
        if ((++sp & 255u) == 0u) { if (xb_ld(&bar[XB_TMO])) break; if (sp > XB_SPIN_CAP) { atomicAdd(&bar[XB_TMO], 1u); break; } }
    }
    nloc = mine > 0u ? mine : 1u; nx = cnt > 0u ? cnt : 1u;
}
__device__ __forceinline__ void xcd_barrier(const XcdBarrier& b, int wave_s) {
    asm volatile("s_waitcnt vmcnt(0)" ::: "memory");
    __syncthreads();
    if (wave_s == 0 && lane_id() == 0) {
        unsigned* bar = b.bar;
        __builtin_amdgcn_s_waitcnt(0);
        unsigned nloc = b.st[0], nx = b.st[1];
        if (nloc == 0u) { xcd_barrier_complete(bar, b.x, nloc, nx); b.st[0] = nloc; b.st[1] = nx; }
        const unsigned old = xb_add(&bar[XB_XSUB(b.x)], 1u);
        const unsigned gen = old / nloc;
        if (old + 1u == (gen + 1u) * nloc) {
            __builtin_amdgcn_fence(__ATOMIC_RELEASE, "agent");
            asm volatile("s_waitcnt vmcnt(0)" ::: "memory");
            const unsigned og = xb_add(&bar[XB_TOP], 1u);
            const unsigned tg = og / nx;
            if (og + 1u == (tg + 1u) * nx) xb_add(&bar[XB_TOPGEN], 1u);
            else XB_SPIN(xb_ld(&bar[XB_TOPGEN]) == tg, bar);
            __builtin_amdgcn_fence(__ATOMIC_ACQUIRE, "agent");
            xb_add(&bar[XB_XGEN(b.x)], 1u);
            asm volatile("s_waitcnt vmcnt(0)" ::: "memory");
        } else {
            XB_SPIN(xb_ld(&bar[XB_XGEN(b.x)]) == gen, bar);
            __builtin_amdgcn_fence(__ATOMIC_ACQUIRE, "agent");
            asm volatile("s_waitcnt vmcnt(0)" ::: "memory");
        }
    }
    __syncthreads();
}

namespace pg8 {
typedef int i32x4v __attribute__((ext_vector_type(4)));
typedef int i32x8v __attribute__((ext_vector_type(8)));
constexpr int BM = 256, BK = 64, HALF = 128, HTB = HALF * BK * 2, STAGE_BYTES = 8 * HTB, NXCD = 8, WGM = 4;
__device__ __forceinline__ int lds_byte(int r, int c) { const int st = (r >> 4) * 2 + (c >> 5), rr = r & 15, cc = c & 31, ob = rr * 64 + cc * 2; return st * 1024 + (ob ^ (((ob >> 9) & 1) << 5)); }
__device__ __forceinline__ void stage_rc(int b, int& R, int& C) { const int st = b / 1024, sb = b % 1024, swz = sb ^ (((sb >> 9) & 1) << 5); R = (st >> 1) * 16 + swz / 64; C = (st & 1) * 32 + (swz % 64) / 2; }
__device__ __forceinline__ int perm32(int rho) { const int n = rho >> 4, i = rho & 15; return 8 * (i >> 2) + 4 * n + (i & 3); }

struct Unit { int row0, pn, e, slot0; };

__device__ __forceinline__ int xcd_remap(int L, int nwg) {
    const int q = nwg / NXCD, r = nwg % NXCD, xcd = L % NXCD, off = L / NXCD;
    return (xcd < r ? xcd * (q + 1) : r * (q + 1) + (xcd - r) * q) + off;
}
struct DenseOrder {
    static constexpr bool GATHER = false;
    int nM, nN, nwg, G, c; unsigned lda2; const char* Bt; size_t bstep;
    int pn_cut = 1 << 30, pn_add = 0, pn_off = 0, pn_boff = 0;
    __device__ __forceinline__ void init(int M, int N, int K, int lda, const void* Bt_, int G_, int c_) { nM = M / BM; nN = N / BM; nwg = nM * nN; G = G_; c = c_; lda2 = (unsigned)lda * 2u; Bt = (const char*)Bt_; bstep = (size_t)BM * K * 2; }
    __device__ __forceinline__ bool next(int i, Unit& u) const {
        const long L = (long)i * G + c; if (L >= nwg) return false;
        const int wgid = xcd_remap((int)L, nwg);
        const int nig = WGM * nN, gid = wgid / nig, fm = gid * WGM, gsz = (nM - fm) < WGM ? (nM - fm) : WGM;
        const int pm = fm + ((wgid % nig) % gsz); int p = (wgid % nig) / gsz; p += pn_off + (p >= pn_cut ? pn_add : 0); u.pn = p; u.row0 = pm * BM; u.e = 0; u.slot0 = 0; return true;
    }
    __device__ __forceinline__ unsigned atok(const Unit& u, int r) const { return 0u; }
    __device__ __forceinline__ size_t abase(const Unit& u) const { return (size_t)u.row0 * lda2; }
    __device__ __forceinline__ const char* bptr(const Unit& u) const { return Bt + (size_t)(u.pn - pn_boff) * bstep; }
};
template <bool GATHER_>
struct GroupOrder {
    static constexpr bool GATHER = GATHER_;
    const LAS int* cnt; const LAS int* ptile; int ncol, nwg, G, c; unsigned lda2; const char* Bt; size_t bstep, estep; const int* slot_tok;
    __device__ __forceinline__ void init(const LAS int* cnt_, const LAS int* ptile_, int ncol_, int K, int lda, const void* Bt_, size_t estep_, const int* st, int G_, int c_) {
        cnt = cnt_; ptile = ptile_; ncol = ncol_; nwg = ptile_[NE] * ncol_; G = G_; c = c_; lda2 = (unsigned)lda * 2u; Bt = (const char*)Bt_; bstep = (size_t)BM * K * 2; estep = estep_; slot_tok = st; }
    __device__ __forceinline__ bool next(int i, Unit& u) const {
        const long L = (long)i * G + c; if (L >= nwg) return false;
        const int wgid = xcd_remap((int)L, nwg);
        const int p = wgid / ncol; u.pn = wgid - p * ncol;
        const int e = ptile[80 + p];
        u.e = e; u.row0 = p * BM; u.slot0 = (p - ptile[e]) * BM; return true;
    }
    __device__ __forceinline__ unsigned atok(const Unit& u, int r) const {
        const int c = cnt[u.e], s0 = u.slot0 + r, s = s0 < c ? s0 : c - 1; return (unsigned)slot_tok[(size_t)u.e * T + s];
    }
    __device__ __forceinline__ size_t abase(const Unit& u) const { return GATHER ? (size_t)0 : (size_t)u.row0 * lda2; }
    __device__ __forceinline__ const char* bptr(const Unit& u) const { return Bt + (size_t)u.e * estep + (size_t)u.pn * bstep; }
};

struct EpiBf16S {
    static constexpr bool PERM = true, STAGGER = false, DEFER = false;
    bf16_t* O; int ldc; float sc;
    __device__ __forceinline__ void operator()(const f32x4 (&acc)[2][2][4][2], const Unit& u, int wr, int wc, int fr, int fq) const {
        const int row0 = u.row0 + wr * 64 + fr, col0 = u.pn * BM + wc * 32 + 8 * fq;
#pragma unroll
        for (int ai = 0; ai < 2; ++ai)
#pragma unroll
            for (int m = 0; m < 4; ++m) { bf16_t* rowp = O + (size_t)(row0 + ai * HALF + m * 16) * ldc + col0;
#pragma unroll
                for (int bj = 0; bj < 2; ++bj) { const f32x4 v0 = acc[ai][bj][m][0] * sc, v1 = acc[ai][bj][m][1] * sc;
                    u32x4 w; w.x = cvtpk(v0[0], v0[1]); w.y = cvtpk(v0[2], v0[3]); w.z = cvtpk(v1[0], v1[1]); w.w = cvtpk(v1[2], v1[3]);
                    *(u32x4*)(rowp + bj * HALF) = w; } }
    }
};
struct EpiFp8S {
    static constexpr bool PERM = true, STAGGER = (STAGGER_SLEEP > 0), DEFER = (DEFER_STORE != 0);
    unsigned char* O; int ldc; float sc;
    __device__ __forceinline__ void operator()(const f32x4 (&acc)[2][2][4][2], const Unit& u, int wr, int wc, int fr, int fq) const {
        const int row0 = u.row0 + wr * 64 + fr, col0 = u.pn * BM + wc * 64 + 16 * fq;
#pragma unroll
        for (int ai = 0; ai < 2; ++ai)
#pragma unroll
            for (int m = 0; m < 4; ++m) { unsigned char* rowp = O + (size_t)(row0 + ai * HALF + m * 16) * ldc + col0;
                f32x4 a0 = acc[ai][0][m][0], a1 = acc[ai][0][m][1], b0 = acc[ai][1][m][0], b1 = acc[ai][1][m][1];
                if constexpr (Y_SCALE != W2_SCALE) { a0 = a0 * sc; a1 = a1 * sc; b0 = b0 * sc; b1 = b1 * sc; }
                u32x4 w; w.x = pk4_fp8(a0[0], a0[1], a0[2], a0[3]); w.y = pk4_fp8(a1[0], a1[1], a1[2], a1[3]); w.z = pk4_fp8(b0[0], b0[1], b0[2], b0[3]); w.w = pk4_fp8(b1[0], b1[1], b1[2], b1[3]);
                *(u32x4*)rowp = w; }
    }
    __device__ __forceinline__ u32x4 pack_row(const f32x4 (&acc)[2][2][4][2], int ai, int m) const {
        f32x4 a0 = acc[ai][0][m][0], a1 = acc[ai][0][m][1], b0 = acc[ai][1][m][0], b1 = acc[ai][1][m][1];
        if constexpr (Y_SCALE != W2_SCALE) { a0 = a0 * sc; a1 = a1 * sc; b0 = b0 * sc; b1 = b1 * sc; }
        u32x4 w; w.x = pk4_fp8(a0[0], a0[1], a0[2], a0[3]); w.y = pk4_fp8(a1[0], a1[1], a1[2], a1[3]); w.z = pk4_fp8(b0[0], b0[1], b0[2], b0[3]); w.w = pk4_fp8(b1[0], b1[1], b1[2], b1[3]);
        return w;
    }
    __device__ __forceinline__ void pack(const f32x4 (&acc)[2][2][4][2], u32x4 (&pend)[4]) const {
#pragma unroll
        for (int m = 0; m < 4; ++m) pend[m] = pack_row(acc, 0, m);
    }
    __device__ __forceinline__ void store_all(const f32x4 (&acc)[2][2][4][2], const u32x4 (&pend)[4], int urow0, int upn, int wr, int wc, int fr, int fq) const {
        const int row0 = urow0 + wr * 64 + fr, col0 = upn * BM + wc * 64 + 16 * fq;
#pragma unroll
        for (int m = 0; m < 4; ++m) *(u32x4*)(O + (size_t)(row0 + m * 16) * ldc + col0) = pend[m];
#pragma unroll
        for (int m = 0; m < 4; ++m) *(u32x4*)(O + (size_t)(row0 + HALF + m * 16) * ldc + col0) = pack_row(acc, 1, m);
    }
};
template <bool XBF>
struct EpiResidT {
    static constexpr bool PERM = true, STAGGER = false, DEFER = false;
    const void* xin; bf16_t* xout; const float* gate; float sc;
    __device__ __forceinline__ void operator()(const f32x4 (&acc)[2][2][4][2], const Unit& u, int wr, int wc, int fr, int fq) const {
        const int row0 = u.row0 + wr * 64 + fr, col0 = u.pn * BM + wc * 32 + 8 * fq;
        const float* gb = gate + (size_t)(u.row0 / SEQ) * (6 * DM) + col0;
        f32x4 gv[2][2];
#pragma unroll
        for (int bj = 0; bj < 2; ++bj)
#pragma unroll
            for (int n = 0; n < 2; ++n) gv[bj][n] = *(const f32x4*)(gb + bj * HALF + 4 * n) * sc;
#pragma unroll
        for (int ai = 0; ai < 2; ++ai)
#pragma unroll
            for (int m = 0; m < 4; ++m) { const size_t off = (size_t)(row0 + ai * HALF + m * 16) * DM + col0;
#pragma unroll
                for (int bj = 0; bj < 2; ++bj) { f32x4 x0, x1;
                    if constexpr (XBF) { const u32x4 w = *(const u32x4*)((const bf16_t*)xin + off + bj * HALF); x0 = (f32x4){bflo(w.x), bfhi(w.x), bflo(w.y), bfhi(w.y)}; x1 = (f32x4){bflo(w.z), bfhi(w.z), bflo(w.w), bfhi(w.w)}; }
                    else { x0 = *(const f32x4*)((const float*)xin + off + bj * HALF); x1 = *(const f32x4*)((const float*)xin + off + bj * HALF + 4); }
                    x0 = x0 + gv[bj][0] * acc[ai][bj][m][0]; x1 = x1 + gv[bj][1] * acc[ai][bj][m][1];
                    u32x4 o; o.x = cvtpk(x0[0], x0[1]); o.y = cvtpk(x0[2], x0[3]); o.z = cvtpk(x1[0], x1[1]); o.w = cvtpk(x1[2], x1[3]);
                    *(u32x4*)(xout + off + bj * HALF) = o; } }
    }
};
__device__ __forceinline__ float silu_mul(float g, float u) { return g * __builtin_amdgcn_rcpf(1.f + __builtin_amdgcn_exp2f(-1.4426950408889634f * g)) * u; }
template <bool OUT8>
struct EpiSwigluT {
    static constexpr bool STAGGER = false, DEFER = false;
    static constexpr bool PERM = true;
    bf16_t* O; int ldc; float sc;
    __device__ __forceinline__ void operator()(const f32x4 (&acc)[2][2][4][2], const Unit& u, int wr, int wc, int fr, int fq) const {
        const int row0 = u.row0 + wr * 64 + fr, col0 = u.pn * HALF + wc * 32 + 8 * fq;
        if constexpr (OUT8) {
            const int colb = u.pn * HALF + wc * 32 + 16 * (fq >> 1);
#pragma unroll
            for (int ai = 0; ai < 2; ++ai)
#pragma unroll
                for (int m = 0; m < 4; m += 2) {
                    unsigned px[2], py[2];
#pragma unroll
                    for (int q = 0; q < 2; ++q) { const f32x4 g0 = acc[ai][0][m + q][0] * sc, g1 = acc[ai][0][m + q][1] * sc, u0 = acc[ai][1][m + q][0] * sc, u1 = acc[ai][1][m + q][1] * sc;
                        px[q] = pk4_fp8(silu_mul(g0[0], u0[0]), silu_mul(g0[1], u0[1]), silu_mul(g0[2], u0[2]), silu_mul(g0[3], u0[3]));
                        py[q] = pk4_fp8(silu_mul(g1[0], u1[0]), silu_mul(g1[1], u1[1]), silu_mul(g1[2], u1[2]), silu_mul(g1[3], u1[3])); }
                    const auto sx = __builtin_amdgcn_permlane16_swap(px[0], px[1], false, false), sy = __builtin_amdgcn_permlane16_swap(py[0], py[1], false, false);
                    u32x4 w; w.x = sx[0]; w.y = sy[0]; w.z = sx[1]; w.w = sy[1];
                    *(u32x4*)((unsigned char*)O + (size_t)(row0 + ai * HALF + (m + (fq & 1)) * 16) * ldc + colb) = w; }
        } else {
#pragma unroll
        for (int ai = 0; ai < 2; ++ai)
#pragma unroll
            for (int m = 0; m < 4; ++m) { bf16_t* rowp = O + (size_t)(row0 + ai * HALF + m * 16) * ldc + col0;
                const f32x4 g0 = acc[ai][0][m][0] * sc, g1 = acc[ai][0][m][1] * sc, u0 = acc[ai][1][m][0] * sc, u1 = acc[ai][1][m][1] * sc;
                u32x4 w; w.x = cvtpk(silu_mul(g0[0], u0[0]), silu_mul(g0[1], u0[1])); w.y = cvtpk(silu_mul(g0[2], u0[2]), silu_mul(g0[3], u0[3]));
                w.z = cvtpk(silu_mul(g1[0], u1[0]), silu_mul(g1[1], u1[1])); w.w = cvtpk(silu_mul(g1[2], u1[2]), silu_mul(g1[3], u1[3]));
                *(u32x4*)rowp = w; }
        }
    }
};

typedef EpiSwigluT<false> EpiSwiglu;
typedef EpiSwigluT<true> EpiSwiglu8;
template <class Epi, class Sched, bool FP8 = false>
__device__ __forceinline__ void gemm_phase(LAS unsigned char* lds, const int tid, const char* Abase, int K, const Sched& S, const Epi& E) {
    const int wid = __builtin_amdgcn_readfirstlane(tid >> 6), lane = tid & 63, wr = wid >> 2, wc = wid & 3, fr = lane & 15, fq = lane >> 4;
    const int nt = K / BK;
    constexpr bool GA = Sched::GATHER;
    int Rr[2], Cc2[2]; unsigned voffB[2], voffA[2];
#pragma unroll
    for (int i = 0; i < 2; ++i) { int R, C; stage_rc(tid * 16 + i * 8192, R, C); const int Rb = Epi::PERM ? ((R & ~31) + perm32(R & 31)) : R;
        Rr[i] = R; Cc2[i] = C * 2; voffB[i] = (unsigned)(Rb * K + C) * 2u; voffA[i] = (unsigned)R * S.lda2 + (unsigned)C * 2u; }
    const size_t hstepA = (size_t)HALF * S.lda2;
    const size_t kstep = (size_t)(BK * 2);
    const size_t hstep = (size_t)HALF * K * 2;
    const unsigned ldsw = (unsigned)wid * 1024u;
    const int aoff = lds_byte(wr * 64 + fr, fq * 8), boff = lds_byte(wc * 32 + fr, fq * 8);
#define PG8_SA(b, h) (((b) * 2 + (h)) * HTB)
#define PG8_SB(b, h) ((4 + (b) * 2 + (h)) * HTB)
#define PG8_STAGE(bufoff, gbase, voff) do { _Pragma("unroll") for (int _i = 0; _i < 2; ++_i) \
        __builtin_amdgcn_global_load_lds((const unsigned*)((const char*)(gbase) + (voff)[_i]), (LAS unsigned*)(lds + (bufoff) + ldsw + _i * 8192), 16, 0, 0); } while (0)
#define PG8_LDA(dst, b, h) do { _Pragma("unroll") for (int m = 0; m < 4; ++m) _Pragma("unroll") for (int k = 0; k < 2; ++k) dst[m][k] = *(const LAS bf16x8*)(lds + PG8_SA(b, h) + aoff + m * 2048 + k * 1024); } while (0)
#define PG8_LDB(dst, b, h) do { _Pragma("unroll") for (int n = 0; n < 2; ++n) _Pragma("unroll") for (int k = 0; k < 2; ++k) dst[n][k] = *(const LAS bf16x8*)(lds + PG8_SB(b, h) + boff + n * 2048 + k * 1024); } while (0)
#define PG8_MMA(ai, bj, At, Bt) do { __builtin_amdgcn_s_setprio(1); _Pragma("unroll") for (int m = 0; m < 4; ++m) _Pragma("unroll") for (int n = 0; n < 2; ++n) _Pragma("unroll") for (int k = 0; k < 2; ++k) \
        acc[ai][bj][m][n] = __builtin_amdgcn_mfma_f32_16x16x32_bf16(Bt[n][k], At[m][k], acc[ai][bj][m][n], 0, 0, 0); __builtin_amdgcn_s_setprio(0); } while (0)
#define PG8_CAT8(lo, hi) __builtin_shufflevector(lo, hi, 0, 1, 2, 3, 4, 5, 6, 7)
#define PG8_LDA8(dst, b, h) do { _Pragma("unroll") for (int m = 0; m < 4; ++m) { const i32x4v lo_ = *(const LAS i32x4v*)(lds + PG8_SA(b, h) + aoff + m * 2048), hi_ = *(const LAS i32x4v*)(lds + PG8_SA(b, h) + aoff + m * 2048 + 1024); dst[m] = PG8_CAT8(lo_, hi_); } } while (0)
#define PG8_LDB8(dst, b, h) do { _Pragma("unroll") for (int n = 0; n < 2; ++n) { const i32x4v lo_ = *(const LAS i32x4v*)(lds + PG8_SB(b, h) + boff + n * 2048), hi_ = *(const LAS i32x4v*)(lds + PG8_SB(b, h) + boff + n * 2048 + 1024); dst[n] = PG8_CAT8(lo_, hi_); } } while (0)
#define PG8_MMA8(ai, bj, A8, B8) do { __builtin_amdgcn_s_setprio(1); _Pragma("unroll") for (int m = 0; m < 4; ++m) _Pragma("unroll") for (int n = 0; n < 2; ++n) \
        asm volatile("v_mfma_scale_f32_16x16x128_f8f6f4 %0, %1, %2, %0, %3, %3 op_sel_hi:[0,0,0]" : "+v"(acc[ai][bj][m][n]) : "v"(B8[n]), "v"(A8[m]), "v"(one8)); __builtin_amdgcn_s_setprio(0); } while (0)
#define PG8_MMA8Z(ai, bj, A8, B8) do { __builtin_amdgcn_s_setprio(1); _Pragma("unroll") for (int m = 0; m < 4; ++m) _Pragma("unroll") for (int n = 0; n < 2; ++n) \
        asm volatile("v_mfma_scale_f32_16x16x128_f8f6f4 %0, %1, %2, 0, %3, %3 op_sel_hi:[0,0,0]" : "=&v"(acc[ai][bj][m][n]) : "v"(B8[n]), "v"(A8[m]), "v"(one8)); __builtin_amdgcn_s_setprio(0); } while (0)
#define PG8_LA(b, h) do { if constexpr (FP8) PG8_LDA8(A8, b, h); else PG8_LDA(At, b, h); } while (0)
#define PG8_LB0(b, h) do { if constexpr (FP8) PG8_LDB8(B08, b, h); else PG8_LDB(B0, b, h); } while (0)
#define PG8_LB1(b, h) do { if constexpr (FP8) PG8_LDB8(B18, b, h); else PG8_LDB(B1, b, h); } while (0)
#define PG8_MM0(ai, bj) do { if constexpr (FP8) PG8_MMA8(ai, bj, A8, B08); else PG8_MMA(ai, bj, At, B0); } while (0)
#define PG8_MM1(ai, bj) do { if constexpr (FP8) PG8_MMA8(ai, bj, A8, B18); else PG8_MMA(ai, bj, At, B1); } while (0)
#define PG8_MM0F(ai, bj) do { if constexpr (FP8) { if (t == 0) PG8_MMA8Z(ai, bj, A8, B08); else PG8_MMA8(ai, bj, A8, B08); } else PG8_MMA(ai, bj, At, B0); } while (0)
#define PG8_MM1F(ai, bj) do { if constexpr (FP8) { if (t == 0) PG8_MMA8Z(ai, bj, A8, B18); else PG8_MMA8(ai, bj, A8, B18); } else PG8_MMA(ai, bj, At, B1); } while (0)
#define PG8_WAIT_V(n) asm volatile("s_waitcnt vmcnt(" #n ")" ::: "memory")
#define PG8_WAIT_L(n) asm volatile("s_waitcnt lgkmcnt(" #n ")" ::: "memory")
#define PG8_BAR __builtin_amdgcn_s_barrier()
#define PG8_SCHED __builtin_amdgcn_sched_barrier(0)
    Unit cur, nxt; int ui = 0;
    if (!S.next(0, cur)) return;
    u32x4 pend[4]; int pend_row0 = 0, pend_pn = 0; bool have_pend = false;
    if constexpr (Epi::STAGGER) { for (int g = (S.c >> 3) & 7; g > 0; --g) __builtin_amdgcn_s_sleep(STAGGER_SLEEP); }
    f32x4 acc[2][2][4][2];
    if constexpr (!FP8)
#pragma unroll
    for (int a = 0; a < 2; ++a)
#pragma unroll
        for (int b = 0; b < 2; ++b)
#pragma unroll
            for (int m = 0; m < 4; ++m)
#pragma unroll
                for (int n = 0; n < 2; ++n) acc[a][b][m][n] = (f32x4){0.f, 0.f, 0.f, 0.f};
    bf16x8 At[4][2], B0[2][2], B1[2][2];
    i32x8v A8[4], B08[2], B18[2];
    const int one8 = 0x7F7F7F7F;
    unsigned pkL[2] = {0u, 0u};
    unsigned pkC[2], tn0[2], tn1[2];
#pragma unroll
    for (int i = 0; i < 2; ++i) { if constexpr (GA) pkC[i] = S.atok(cur, Rr[i]) | (S.atok(cur, HALF + Rr[i]) << 16); else pkC[i] = 0u; tn0[i] = pkC[i] & 0xffffu; tn1[i] = pkC[i] >> 16; }
#define PG8_AOFF(dst, pk, hsel) do { _Pragma("unroll") for (int _j = 0; _j < 2; ++_j) { if constexpr (GA) dst[_j] = ((hsel) ? ((pk)[_j] >> 16) : ((pk)[_j] & 0xffffu)) * S.lda2 + (unsigned)Cc2[_j]; else dst[_j] = voffA[_j]; } } while (0)
    unsigned vC0[2], vC1[2]; PG8_AOFF(vC0, pkC, 0); PG8_AOFF(vC1, pkC, 1);
    const char* cB = S.bptr(cur);
    const char* cA = Abase + S.abase(cur);
    const size_t hA = GA ? (size_t)0 : hstepA;
    PG8_STAGE(PG8_SB(0, 0), cB, voffB); PG8_STAGE(PG8_SA(0, 0), cA, vC0); PG8_STAGE(PG8_SB(0, 1), cB + hstep, voffB); PG8_STAGE(PG8_SA(0, 1), cA + hA, vC1);
    if (wr == 1) PG8_BAR;
    PG8_WAIT_V(4); PG8_BAR;
    PG8_STAGE(PG8_SB(1, 0), cB + kstep, voffB); PG8_STAGE(PG8_SA(1, 0), cA + kstep, vC0); PG8_STAGE(PG8_SB(1, 1), cB + hstep + kstep, voffB);
    PG8_WAIT_V(6); PG8_BAR;
    for (;;) {
        const bool has_next = S.next(ui + 1, nxt);
        const char* nB = has_next ? S.bptr(nxt) : cB;
        const char* nA = has_next ? Abase + S.abase(nxt) : cA;
        if constexpr (GA) {
#pragma unroll
            for (int i = 0; i < 2; ++i) { if (has_next) { tn0[i] = S.atok(nxt, Rr[i]); tn1[i] = S.atok(nxt, HALF + Rr[i]); } }
        }
        for (int t = 0; t < nt; t += 2) {
            const bool last = (t == nt - 2);
            const char* a1 = cA + (size_t)(t + 1) * kstep;
            const char* a2 = last ? nA : cA + (size_t)(t + 2) * kstep; const char* b2 = last ? nB : cB + (size_t)(t + 2) * kstep;
            const char* a3 = a2 + kstep; const char* b3 = b2 + kstep;
            unsigned pks[2], w0[2], w1[2], c1[2];
            if constexpr (GA) { if (last) { asm volatile("" : "+v"(tn0[0]), "+v"(tn0[1]), "+v"(tn1[0]), "+v"(tn1[1]));
                                         pkL[0] = tn0[0] | (tn1[0] << 16); pkL[1] = tn0[1] | (tn1[1] << 16); pks[0] = pkL[0]; pks[1] = pkL[1]; } else { pks[0] = pkC[0]; pks[1] = pkC[1]; } }
            else { pks[0] = 0u; pks[1] = 0u; }
            PG8_AOFF(c1, pkC, 1);
            PG8_LB0(0, 0); PG8_SCHED; PG8_LA(0, 0); PG8_STAGE(PG8_SA(1, 1), a1 + hA, c1);
            PG8_WAIT_L(8); PG8_BAR; PG8_WAIT_L(0); PG8_MM0F(0, 0); PG8_BAR; PG8_SCHED;
            if constexpr (Epi::DEFER) { if (t == 0 && have_pend) { E.store_all(acc, pend, pend_row0, pend_pn, wr, wc, fr, fq); PG8_SCHED; } }
            PG8_LB1(0, 1); PG8_STAGE(PG8_SB(0, 0), b2, voffB);
            PG8_BAR; PG8_WAIT_L(0); PG8_MM1F(0, 1); PG8_BAR;
            PG8_LA(0, 1); PG8_AOFF(w0, pks, 0); PG8_STAGE(PG8_SA(0, 0), a2, w0);
            PG8_BAR; PG8_WAIT_L(0); PG8_MM0F(1, 0); PG8_BAR; PG8_SCHED;
            PG8_STAGE(PG8_SB(0, 1), b2 + hstep, voffB);
            if constexpr (Epi::DEFER) { if (t == 0 && have_pend) PG8_WAIT_V(14); else PG8_WAIT_V(6); } else PG8_WAIT_V(6);
            PG8_BAR; PG8_MM1F(1, 1); PG8_BAR;
            PG8_LB0(1, 0); PG8_SCHED; PG8_LA(1, 0); PG8_AOFF(w1, pks, 1); PG8_STAGE(PG8_SA(0, 1), a2 + hA, w1);
            PG8_WAIT_L(8); PG8_BAR; PG8_WAIT_L(0); PG8_MM0(0, 0); PG8_BAR; PG8_SCHED;
            PG8_LB1(1, 1); PG8_STAGE(PG8_SB(1, 0), b3, voffB);
            PG8_BAR; PG8_WAIT_L(0); PG8_MM1(0, 1); PG8_BAR;
            PG8_LA(1, 1); PG8_AOFF(w0, pks, 0); PG8_STAGE(PG8_SA(1, 0), a3, w0);
            PG8_BAR; PG8_WAIT_L(0); PG8_MM0(1, 0); PG8_BAR; PG8_SCHED;
            PG8_STAGE(PG8_SB(1, 1), b3 + hstep, voffB);
            PG8_WAIT_V(6); PG8_BAR; PG8_MM1(1, 1); PG8_BAR;
        }
        if constexpr (FP8) asm volatile("s_nop 15\n\ts_nop 15" ::: "memory");
        if constexpr (Epi::DEFER) { if (has_next) { E.pack(acc, pend); pend_row0 = cur.row0; pend_pn = cur.pn; have_pend = true; } else E(acc, cur, wr, wc, fr, fq); }
        else E(acc, cur, wr, wc, fr, fq);
#ifdef PROBE_EPI2
        if constexpr (FP8 && !Sched::GATHER) { asm volatile("" ::: "memory"); E(acc, cur, wr, wc, fr, fq); }
#endif
        if (!has_next) break;
        if constexpr (!FP8)
#pragma unroll
        for (int a = 0; a < 2; ++a)
#pragma unroll
            for (int b = 0; b < 2; ++b)
#pragma unroll
                for (int m = 0; m < 4; ++m)
#pragma unroll
                    for (int n = 0; n < 2; ++n) acc[a][b][m][n] = (f32x4){0.f, 0.f, 0.f, 0.f};
        cur = nxt; cB = nB; cA = nA; ++ui;
        if constexpr (GA) {
#pragma unroll
            for (int i = 0; i < 2; ++i) pkC[i] = pkL[i];
        }
    }
    PG8_WAIT_V(0);
    if (wr == 0) PG8_BAR;
    PG8_BAR;
#undef PG8_AOFF
#undef PG8_SA
#undef PG8_SB
#undef PG8_STAGE
#undef PG8_LDA
#undef PG8_LDB
#undef PG8_MMA
#undef PG8_MMA8
#undef PG8_CAT8
#undef PG8_LDA8
#undef PG8_LDB8
#undef PG8_LA
#undef PG8_LB0
#undef PG8_LB1
#undef PG8_MM0
#undef PG8_MM1
#undef PG8_WAIT_V
#undef PG8_WAIT_L
#undef PG8_BAR
#undef PG8_SCHED
}
}

struct Args { const float* in[23]; float* out; unsigned char* ws; int ph_lo, ph_hi; };
typedef const __attribute__((address_space(4))) Args* ArgsP;
struct Ctx {
    ArgsP ap; float* out; unsigned char* ws;
    char* lds;
    LAS unsigned char* ldsl;
    int tid, lane, wave, G, bid, gw, NGW, vcu;
};
__device__ __forceinline__ void ctx_init(Ctx& C, unsigned char* lds, int wave_s) {
    int tid = wave_s * 64 + lane_id(), bid = blockIdx.x, G = gridDim.x;
    asm volatile("" : "+v"(tid)); asm volatile("" : "+s"(bid)); asm volatile("" : "+s"(G));
    ArgsP ap = (ArgsP)__builtin_amdgcn_kernarg_segment_ptr(); asm volatile("" : "+s"(ap));
    unsigned lb = 0u; asm volatile("" : "+s"(lb));
    C.ap = ap; C.out = ap->out; C.ws = ap->ws; C.lds = (char*)lds + lb; C.ldsl = (LAS unsigned char*)lds + lb;
    C.tid = tid; C.lane = tid & 63; C.wave = __builtin_amdgcn_readfirstlane(tid >> 6); C.G = G; C.bid = bid;
    C.gw = bid * NWAVES + C.wave; C.NGW = G * NWAVES;
    C.vcu = (G % 8 == 0) ? (bid % 8) * (G / 8) + bid / 8 : bid;
}
enum { I_X = 0, I_C, I_POS, I_NMG, I_NFG, I_WADA, I_BADA, I_WIN, I_GCQ, I_GCKV, I_WUQ, I_WUKV, I_GOUT, I_WO, I_WR, I_BR, I_WG, I_WU, I_WD, I_WSG, I_WSU, I_WSD, I_FG };

__device__ __forceinline__ void cvt_tile(const float* W, int ldw, int ncols, int k0, int n0, bf16_t* WT, int ldt, int dst_row0, LAS float* scr, int lane) {
    f32x4 v[16];
    const int kr = lane >> 4, nc = (lane & 15) * 4;
    const bool ok = (n0 + nc) < ncols;
#pragma unroll
    for (int i = 0; i < 16; ++i) v[i] = ok ? __builtin_nontemporal_load((const f32x4*)(W + (size_t)(k0 + kr + 4 * i) * ldw + n0 + nc)) : (f32x4){0.f, 0.f, 0.f, 0.f};
#pragma unroll
    for (int i = 0; i < 16; ++i) { LAS float* s = scr + (kr + 4 * i) * 65 + nc; s[0] = v[i][0]; s[1] = v[i][1]; s[2] = v[i][2]; s[3] = v[i][3]; }
    LDS_WAIT();
    const int c = lane >> 3, nn = lane & 7;
#pragma unroll
    for (int j = 0; j < 8; ++j) { const int n = nn + 8 * j; const LAS float* s = scr + (8 * c) * 65 + n;
        u32x4 o; o.x = cvtpk(s[0], s[65]); o.y = cvtpk(s[2 * 65], s[3 * 65]); o.z = cvtpk(s[4 * 65], s[5 * 65]); o.w = cvtpk(s[6 * 65], s[7 * 65]);
        *(u32x4*)(WT + (size_t)(dst_row0 + n) * ldt + k0 + 8 * c) = o; }
    LDS_WAIT();
}
template <bool IL = false>
__device__ __forceinline__ void cvt_tile_f8(const float* W, int ldw, int ncols, int k0, int n0, unsigned char* WT8, int ldt, int dst_row0, float scale, LAS float* scr, int lane) {
    f32x4 v[16];
    const int kr = lane >> 4, nc = (lane & 15) * 4;
    const bool ok = (n0 + nc) < ncols;
#pragma unroll
    for (int i = 0; i < 16; ++i) v[i] = ok ? __builtin_nontemporal_load((const f32x4*)(W + (size_t)(k0 + kr + 4 * i) * ldw + n0 + nc)) : (f32x4){0.f, 0.f, 0.f, 0.f};
#pragma unroll
    for (int i = 0; i < 16; ++i) { LAS float* s = scr + (kr + 4 * i) * 65 + nc; s[0] = v[i][0]; s[1] = v[i][1]; s[2] = v[i][2]; s[3] = v[i][3]; }
    LDS_WAIT();
    const int c = lane >> 3, nn = lane & 7;
#pragma unroll
    for (int j = 0; j < 8; ++j) { const int n = nn + 8 * j; const LAS float* s = scr + (8 * c) * 65 + n;
        u32x2 o; o.x = pk4_fp8(s[0] * scale, s[65] * scale, s[2 * 65] * scale, s[3 * 65] * scale); o.y = pk4_fp8(s[4 * 65] * scale, s[5 * 65] * scale, s[6 * 65] * scale, s[7 * 65] * scale);
        const int drow = IL ? (dst_row0 + (j & 1) * 128 + 8 * (j >> 1) + nn) : (dst_row0 + n);
        *(u32x2*)(WT8 + (size_t)drow * ldt + k0 + 8 * c) = o; }
    LDS_WAIT();
}
__device__ __forceinline__ int gu_row(int n0, int up) { return (n0 >> 7) * 256 + up * 128 + (n0 & 127); }

constexpr int I_IN = 32 * 68, I_UQ = 8 * 24, I_UKV = 4 * 32, I_O = 32 * 32, I_SG = 32 * 8, I_SD = 8 * 32, I_RT = 32, I_EG = 32 * 8, I_ED = 8 * 32;
constexpr int I_SMALL = I_IN + I_UQ + I_UKV + I_O + 2 * I_SG + I_SD + I_RT;
constexpr int I_EXP = NE * (2 * I_EG + I_ED);
__device__ __forceinline__ void cvt_small_item(const Ctx& C, int l, int r, LAS float* scr) {
    unsigned char* wl = C.ws + WS_W + (size_t)l * LW_BYTES;
    if (r < I_IN) { const int kt = r / 68, ntl = r % 68; const int ct = ntl >> 2;
                    const bool f8 = (WIN_FP8 == 1) || (WIN_FP8 == 2 && (ct < WIN_B0 || ct >= WIN_B0 + WIN_NB));
                    if (f8) cvt_tile_f8(C.ap->in[I_WIN] + (size_t)l * DM * INW, INW, INW, kt * 64, ntl * 64, wl + LW_IN, DM, ntl * 64, W1_SCALE, scr, C.lane);
                    else if (WIN_FP8 == 2) cvt_tile(C.ap->in[I_WIN] + (size_t)l * DM * INW, INW, INW, kt * 64, ntl * 64, (bf16_t*)(wl + LW_IN + (size_t)NPROJ * DM), DM, ntl * 64 - WIN_B0 * 256, scr, C.lane);
                    else cvt_tile(C.ap->in[I_WIN] + (size_t)l * DM * INW, INW, INW, kt * 64, ntl * 64, (bf16_t*)(wl + LW_IN), DM, ntl * 64, scr, C.lane); return; } r -= I_IN;
    if (r < I_UQ) { const int kt = r / 24, ntl = r % 24; if (UQ_FP8) cvt_tile_f8(C.ap->in[I_WUQ] + (size_t)l * 512 * 1536, 1536, 1536, kt * 64, ntl * 64, wl + LW_UQ, 512, ntl * 64, W1_SCALE, scr, C.lane);
                    else cvt_tile(C.ap->in[I_WUQ] + (size_t)l * 512 * 1536, 1536, 1536, kt * 64, ntl * 64, (bf16_t*)(wl + LW_UQ), 512, ntl * 64, scr, C.lane); return; } r -= I_UQ;
    if (r < I_UKV) { const int kt = r / 32, ntl = r % 32; cvt_tile(C.ap->in[I_WUKV] + (size_t)l * 256 * 2048, 2048, 2048, kt * 64, ntl * 64, (bf16_t*)(wl + LW_UKV), 256, ntl * 64, scr, C.lane); return; } r -= I_UKV;
    if (r < I_O) { const int kt = r / 32, ntl = r % 32; if (WO_FP8) cvt_tile_f8(C.ap->in[I_WO] + (size_t)l * DM * DM, DM, DM, kt * 64, ntl * 64, wl + LW_O, DM, ntl * 64, W1_SCALE, scr, C.lane);
                    else cvt_tile(C.ap->in[I_WO] + (size_t)l * DM * DM, DM, DM, kt * 64, ntl * 64, (bf16_t*)(wl + LW_O), DM, ntl * 64, scr, C.lane); return; } r -= I_O;
    if (r < I_SG) { const int kt = r / 8, ntl = r % 8; if (SH_FP8) cvt_tile_f8(C.ap->in[I_WSG] + (size_t)l * DM * 512, 512, 512, kt * 64, ntl * 64, wl + LW_S1, DM, gu_row(ntl * 64, 0), W1_SCALE, scr, C.lane);
                    else cvt_tile(C.ap->in[I_WSG] + (size_t)l * DM * 512, 512, 512, kt * 64, ntl * 64, (bf16_t*)(wl + LW_S1), DM, gu_row(ntl * 64, 0), scr, C.lane); return; } r -= I_SG;
    if (r < I_SG) { const int kt = r / 8, ntl = r % 8; if (SH_FP8) cvt_tile_f8(C.ap->in[I_WSU] + (size_t)l * DM * 512, 512, 512, kt * 64, ntl * 64, wl + LW_S1, DM, gu_row(ntl * 64, 1), W1_SCALE, scr, C.lane);
                    else cvt_tile(C.ap->in[I_WSU] + (size_t)l * DM * 512, 512, 512, kt * 64, ntl * 64, (bf16_t*)(wl + LW_S1), DM, gu_row(ntl * 64, 1), scr, C.lane); return; } r -= I_SG;
    if (r < I_SD) { const int kt = r / 32, ntl = r % 32; if (SH_FP8) cvt_tile_f8<true>(C.ap->in[I_WSD] + (size_t)l * 512 * DM, DM, DM, kt * 64, ntl * 64, wl + LW_S2, 512, (ntl >> 2) * 256 + (ntl & 3) * 32, W2_SCALE, scr, C.lane);
                    else cvt_tile(C.ap->in[I_WSD] + (size_t)l * 512 * DM, DM, DM, kt * 64, ntl * 64, (bf16_t*)(wl + LW_S2), 512, ntl * 64, scr, C.lane); return; } r -= I_SD;
    cvt_tile(C.ap->in[I_WR] + (size_t)l * DM * 64, 64, 64, r * 64, 0, (bf16_t*)(wl + LW_R), DM, 0, scr, C.lane);
}
__device__ __forceinline__ void cvt_expert_item(const Ctx& C, int l, int r, LAS float* scr) {
    unsigned char* wl = C.ws + WS_W + (size_t)l * LW_BYTES;
    const int e = r / (2 * I_EG + I_ED); r -= e * (2 * I_EG + I_ED);
    const size_t eo = ((size_t)l * NE + e);
    if (r < I_EG) { const int kt = r / 8, ntl = r % 8; cvt_tile_f8(C.ap->in[I_WG] + eo * DM * 512, 512, 512, kt * 64, ntl * 64, wl + LW_1 + (size_t)e * 1024 * DM, DM, gu_row(ntl * 64, 0), W1_SCALE, scr, C.lane); return; } r -= I_EG;
    if (r < I_EG) { const int kt = r / 8, ntl = r % 8; cvt_tile_f8(C.ap->in[I_WU] + eo * DM * 512, 512, 512, kt * 64, ntl * 64, wl + LW_1 + (size_t)e * 1024 * DM, DM, gu_row(ntl * 64, 1), W1_SCALE, scr, C.lane); return; } r -= I_EG;
    { const int kt = r / 32, ntl = r % 32; cvt_tile_f8<true>(C.ap->in[I_WD] + eo * 512 * DM, DM, DM, kt * 64, ntl * 64, wl + LW_2 + (size_t)e * DM * 512, 512, (ntl >> 2) * 256 + (ntl & 3) * 32, W2_SCALE, scr, C.lane); }
}
__device__ __forceinline__ void phase_convert(const Ctx& C) {
    LAS float* scr = (LAS float*)(C.ldsl + C.wave * 16640);
    for (int it = C.gw; it < NL * I_SMALL; it += C.NGW) { const int l = it / I_SMALL; cvt_small_item(C, l, it - l * I_SMALL, scr); }
}
constexpr int CW_Q = 16384;
__device__ __forceinline__ void cvt_fill(const Ctx& C, unsigned target_arrivals) {
    unsigned long long* q0 = (unsigned long long*)((unsigned*)(C.ws + WS_CTL) + CW_Q); unsigned long long* q1 = q0 + 32;
    LAS int* wrd = (LAS int*)(C.ldsl + LDS_MISC + 64);
    LAS float* scr = (LAS float*)(C.ldsl + C.wave * 16640);
    __syncthreads();
    if (C.tid == 0) (void)__hip_atomic_fetch_add(q0, 1ull << 32, __ATOMIC_RELAXED, __HIP_MEMORY_SCOPE_AGENT);
    for (;;) {
        if (C.tid == 0) {
            const unsigned long long old = __hip_atomic_fetch_add(q0, 8ull, __ATOMIC_RELAXED, __HIP_MEMORY_SCOPE_AGENT);
            int idx = (int)(unsigned)(old & 0xffffffffull), lay = 0;
            if (idx >= I_EXP) { idx = (int)(unsigned)(__hip_atomic_fetch_add(q1, 8ull, __ATOMIC_RELAXED, __HIP_MEMORY_SCOPE_AGENT) & 0xffffffffull); lay = 1; }
            wrd[0] = idx; wrd[1] = lay; wrd[2] = ((unsigned)(old >> 32) >= target_arrivals) ? 1 : 0;
        }
        __syncthreads();
        const int idx = wrd[0], lay = wrd[1], last = wrd[2];
        __syncthreads();
#ifdef PROBE_EXTRA
        if (idx < I_EXP + (lay ? PROBE_EXTRA : 0)) cvt_expert_item(C, lay, (idx + C.wave) % I_EXP, scr);
#else
        if (idx < I_EXP) cvt_expert_item(C, lay, idx + C.wave, scr);
#endif
        else break;
        if (last) break;
    }
}
__device__ __forceinline__ void cvt_quota(const Ctx& C, int rounds) {
    unsigned long long* q0 = (unsigned long long*)((unsigned*)(C.ws + WS_CTL) + CW_Q); unsigned long long* q1 = q0 + 32;
    LAS int* wrd = (LAS int*)(C.ldsl + LDS_MISC + 64);
    LAS float* scr = (LAS float*)(C.ldsl + C.wave * 16640);
    __syncthreads();
#pragma unroll 1
    for (int r = 0; r < rounds; ++r) {
        if (C.tid == 0) {
            int idx = (int)(unsigned)(__hip_atomic_fetch_add(q0, 8ull, __ATOMIC_RELAXED, __HIP_MEMORY_SCOPE_AGENT) & 0xffffffffull), lay = 0;
            if (idx >= I_EXP) { idx = (int)(unsigned)(__hip_atomic_fetch_add(q1, 8ull, __ATOMIC_RELAXED, __HIP_MEMORY_SCOPE_AGENT) & 0xffffffffull); lay = 1; }
            wrd[0] = idx; wrd[1] = lay;
        }
        __syncthreads();
        const int idx = wrd[0], lay = wrd[1];
        __syncthreads();
        if (idx >= I_EXP) break;
        cvt_expert_item(C, lay, idx + C.wave, scr);
    }
    __syncthreads();
}
__device__ __forceinline__ void cvt_drain(const Ctx& C, int l) {
    unsigned long long* q = (unsigned long long*)((unsigned*)(C.ws + WS_CTL) + CW_Q) + 32 * l;
    LAS int* wrd = (LAS int*)(C.ldsl + LDS_MISC + 64);
    LAS float* scr = (LAS float*)(C.ldsl + C.wave * 16640);
    __syncthreads();
    for (;;) {
        if (C.tid == 0) wrd[0] = (int)(unsigned)(__hip_atomic_fetch_add(q, 8ull, __ATOMIC_RELAXED, __HIP_MEMORY_SCOPE_AGENT) & 0xffffffffull);
        __syncthreads();
        const int idx = wrd[0];
        __syncthreads();
#ifdef PROBE_EXTRA
        if (idx >= I_EXP + (l ? PROBE_EXTRA : 0)) break;
        cvt_expert_item(C, l, (idx + C.wave) % I_EXP, scr);
#else
        if (idx >= I_EXP) break;
        cvt_expert_item(C, l, idx + C.wave, scr);
#endif
    }
}

__device__ __forceinline__ void phase_adaln(const Ctx& C) {
    LAS float* sc = (LAS float*)C.ldsl;
    LAS float* red = (LAS float*)(C.ldsl + 65536);
    constexpr int NIT = NL * (6 * DM) / 128;
    if (C.bid >= NIT) return;
    for (int i = C.tid; i < NB * DM; i += NTHR) { const int b = i / DM, k = i % DM; const float v = C.ap->in[I_C][i]; sc[k * 8 + b] = v / (1.f + __expf(-v)); }
    __syncthreads();
    for (int it = C.bid; it < NIT; it += C.G) {
        const int l = it / (6 * DM / 128), n = (it % (6 * DM / 128)) * 128 + (C.tid & 127), kq = C.tid >> 7;
        const float* w = C.ap->in[I_WADA] + (size_t)l * DM * (6 * DM) + n;
        float a[8] = {0.f, 0.f, 0.f, 0.f, 0.f, 0.f, 0.f, 0.f};
        for (int k0 = kq * 512; k0 < kq * 512 + 512; k0 += 32) {
            float wv[32];
#pragma unroll
            for (int j = 0; j < 32; ++j) wv[j] = __builtin_nontemporal_load(w + (size_t)(k0 + j) * (6 * DM));
#pragma unroll
            for (int j = 0; j < 32; ++j) { const f32x4 s0 = *(const LAS f32x4*)(sc + (k0 + j) * 8), s1 = *(const LAS f32x4*)(sc + (k0 + j) * 8 + 4);
                a[0] += s0[0] * wv[j]; a[1] += s0[1] * wv[j]; a[2] += s0[2] * wv[j]; a[3] += s0[3] * wv[j];
                a[4] += s1[0] * wv[j]; a[5] += s1[1] * wv[j]; a[6] += s1[2] * wv[j]; a[7] += s1[3] * wv[j]; }
        }
#pragma unroll
        for (int b = 0; b < 8; ++b) red[(kq * 128 + (C.tid & 127)) * 8 + b] = a[b];
        __syncthreads();
        if (C.tid < 128) {
            const float bias = C.ap->in[I_BADA][(size_t)l * 6 * DM + n];
            float* mod = (float*)(C.ws + WS_MOD) + (size_t)l * NB * 6 * DM;
#pragma unroll
            for (int b = 0; b < 8; ++b) { const float s = ((red[(0 * 128 + C.tid) * 8 + b] + red[(1 * 128 + C.tid) * 8 + b]) + red[(2 * 128 + C.tid) * 8 + b]) + red[(3 * 128 + C.tid) * 8 + b];
                mod[(size_t)b * 6 * DM + n] = s + bias; }
        }
        __syncthreads();
    }
}

__device__ __forceinline__ void norm_mod_rows(const float* x, const float* g, const float* msh, const float* msc, unsigned char* h8, bf16_t* h, int row0, int nrows, int lane) {
    const int b = row0 / SEQ;
    f32x4 a[8], s[8];
#pragma unroll
    for (int j = 0; j < 8; ++j) { const int col = 4 * lane + 256 * j; const f32x4 gg = *(const f32x4*)(g + col), sc = *(const f32x4*)(msc + (size_t)b * 6 * DM + col);
        a[j] = gg * (sc + 1.f); s[j] = *(const f32x4*)(msh + (size_t)b * 6 * DM + col); }
    for (int r = 0; r < nrows; ++r) {
        const float* xr = x + (size_t)(row0 + r) * DM;
        f32x4 v[8]; float ss = 0.f;
#pragma unroll
        for (int j = 0; j < 8; ++j) { v[j] = *(const f32x4*)(xr + 4 * lane + 256 * j); ss += (v[j][0] * v[j][0] + v[j][1] * v[j][1]) + (v[j][2] * v[j][2] + v[j][3] * v[j][3]); }
        const float rstd = rsqrtf(wave_sum(ss) * (1.f / DM) + EPS);
        unsigned char* hr = h8 + (size_t)(row0 + r) * DM;
#pragma unroll
        for (int j = 0; j < 8; ++j) { const f32x4 y = v[j] * rstd * a[j] + s[j];
            if (WIN_FP8 != 0) *(unsigned*)(hr + 4 * lane + 256 * j) = pk4_fp8(y[0], y[1], y[2], y[3]);
            if (WIN_FP8 != 1) { u32x2 w; w.x = cvtpk(y[0], y[1]); w.y = cvtpk(y[2], y[3]); *(u32x2*)(h + (size_t)(row0 + r) * DM + 4 * lane + 256 * j) = w; } }
    }
}

__device__ __forceinline__ void rope8(u32x4& A, u32x4& B, const LAS float* tb) {
    const f32x4 t0 = *(const LAS f32x4*)tb, t1 = *(const LAS f32x4*)(tb + 4), t2 = *(const LAS f32x4*)(tb + 8), t3 = *(const LAS f32x4*)(tb + 12);
#define R8W(w, ca, sa, cb, sb) do { const float x1a = bflo(A.w), x1b = bfhi(A.w), x2a = bflo(B.w), x2b = bfhi(B.w); \
        A.w = cvtpk(x1a * (ca) - x2a * (sa), x1b * (cb) - x2b * (sb)); B.w = cvtpk(x2a * (ca) + x1a * (sa), x2b * (cb) + x1b * (sb)); } while (0)
    R8W(x, t0[0], t0[1], t0[2], t0[3]); R8W(y, t1[0], t1[1], t1[2], t1[3]); R8W(z, t2[0], t2[1], t2[2], t2[3]); R8W(w, t3[0], t3[1], t3[2], t3[3]);
#undef R8W
}
__device__ __forceinline__ void phase_postproj(const Ctx& C, int l) {
    bf16_t* proj = (bf16_t*)(C.ws + WS_PROJ); float* cs = (float*)(C.ws + WS_CS);
    const float* gcq = C.ap->in[I_GCQ] + (size_t)l * 512; const float* gckv = C.ap->in[I_GCKV] + (size_t)l * 256;
    const int* pos = (const int*)C.ap->in[I_POS];
    const int lane = C.lane;
    LAS float* tab64 = (LAS float*)(C.ldsl + C.wave * 1024); LAS float* tab128 = tab64 + 64;
    const float inv64 = exp2f(-(float)(lane & 31) * (2.f / 64.f) * 13.287712379549449f);
    const float inv128 = exp2f(-(float)lane * (2.f / 128.f) * 13.287712379549449f);
    const int o1 = O_IXQ + (lane >> 2) * 64 + (lane & 3) * 8, t1 = (lane & 3) * 16;
    int o2, d2, t2;
    if (lane < 32) { o2 = O_DSQ + (lane >> 3) * 128 + (lane & 7) * 8; d2 = 64; t2 = 64 + (lane & 7) * 16; }
    else if (lane < 40) { o2 = O_DSK + (lane - 32) * 8; d2 = 64; t2 = 64 + (lane - 32) * 16; }
    else if (lane < 44) { o2 = O_KR + (lane - 40) * 8; d2 = 32; t2 = (lane - 40) * 16; }
    else { o2 = O_IXK + ((lane - 44) & 3) * 8; d2 = 32; t2 = ((lane - 44) & 3) * 16; }
    const bool g2 = lane < 48;
    u32x4 nq, na1, nb1, na2, nb2; u32x2 nk; int npos;
#define PP_LOAD(tt) do { const bf16_t* p_ = proj + (size_t)(tt) * NPROJ; nq = *(const u32x4*)(p_ + O_CQ + lane * 8); nk = *(const u32x2*)(p_ + O_CKV + lane * 4); \
        na1 = *(const u32x4*)(p_ + o1); nb1 = *(const u32x4*)(p_ + o1 + 32); na2 = *(const u32x4*)(p_ + o2); nb2 = *(const u32x4*)(p_ + o2 + d2); npos = pos[tt]; } while (0)
    if (C.gw < T) PP_LOAD(C.gw);
    for (int t = C.gw; t < T; t += C.NGW) {
        bf16_t* p = proj + (size_t)t * NPROJ;
        u32x4 wq = nq; u32x2 wk = nk; u32x4 a1 = na1, b1 = nb1, a2 = na2, b2 = nb2;
        const float ps = (float)npos;
        { const int tn = (t + C.NGW < T) ? t + C.NGW : t; PP_LOAD(tn); }
        { const float t64 = ps * inv64 * 0.15915494309189535f, t128 = ps * inv128 * 0.15915494309189535f;
          const float f64 = t64 - floorf(t64), f128 = t128 - floorf(t128);
          const float s64 = __builtin_amdgcn_sinf(f64), c64 = __builtin_amdgcn_cosf(f64), s128 = __builtin_amdgcn_sinf(f128), c128 = __builtin_amdgcn_cosf(f128);
          if (lane < 32) { *(LAS f32x2*)(tab64 + 2 * lane) = (f32x2){c64, s64}; *(f32x2*)(cs + (size_t)t * 64 + 2 * lane) = (f32x2){c64, s64}; }
          *(LAS f32x2*)(tab128 + 2 * lane) = (f32x2){c128, s128}; }
        { float f[8] = {bflo(wq.x), bfhi(wq.x), bflo(wq.y), bfhi(wq.y), bflo(wq.z), bfhi(wq.z), bflo(wq.w), bfhi(wq.w)};
          float ss = 0.f;
#pragma unroll
          for (int j = 0; j < 8; ++j) ss += f[j] * f[j];
          const float r = rsqrtf(wave_sum(ss) * (1.f / 512.f) + EPS);
          const f32x4 g0 = *(const f32x4*)(gcq + lane * 8), g1 = *(const f32x4*)(gcq + lane * 8 + 4);
          wq.x = cvtpk(f[0] * r * g0[0], f[1] * r * g0[1]); wq.y = cvtpk(f[2] * r * g0[2], f[3] * r * g0[3]); wq.z = cvtpk(f[4] * r * g1[0], f[5] * r * g1[1]); wq.w = cvtpk(f[6] * r * g1[2], f[7] * r * g1[3]);
          *(u32x4*)(p + O_CQ + lane * 8) = wq;
          if (UQ_FP8) { u32x2 w8; w8.x = pk4_fp8(f[0] * r * g0[0], f[1] * r * g0[1], f[2] * r * g0[2], f[3] * r * g0[3]); w8.y = pk4_fp8(f[4] * r * g1[0], f[5] * r * g1[1], f[6] * r * g1[2], f[7] * r * g1[3]);
                        *(u32x2*)(C.ws + WS_CQ8 + (size_t)t * 512 + lane * 8) = w8; } }
        { float f[4] = {bflo(wk.x), bfhi(wk.x), bflo(wk.y), bfhi(wk.y)};
          const float ss = (f[0] * f[0] + f[1] * f[1]) + (f[2] * f[2] + f[3] * f[3]);
          const float r = rsqrtf(wave_sum(ss) * (1.f / 256.f) + EPS);
          const f32x4 g0 = *(const f32x4*)(gckv + lane * 4);
          wk.x = cvtpk(f[0] * r * g0[0], f[1] * r * g0[1]); wk.y = cvtpk(f[2] * r * g0[2], f[3] * r * g0[3]);
          *(u32x2*)(p + O_CKV + lane * 4) = wk; }
        LDS_WAIT();
        rope8(a1, b1, tab64 + t1); rope8(a2, b2, tab64 + t2);
        *(u32x4*)(p + o1) = a1; *(u32x4*)(p + o1 + 32) = b1;
        if (g2) { *(u32x4*)(p + o2) = a2; *(u32x4*)(p + o2 + d2) = b2; }
        LDS_WAIT();
    }
}
#undef PP_LOAD

#define KSWZ(row, colB) ((row) * 256 + ((colB) ^ (((row) & 7) << 4)))
constexpr int SHM_V = 64 * 128 * 2, SHM_K = 64 * 128 * 2, SHM_KR = 64 * 64 * 2;
constexpr int ATT_V = 0, ATT_K = SHM_V, ATT_KR = SHM_V + SHM_K, ATT_WS = ATT_KR + SHM_KR;
__device__ __forceinline__ int v_st(int k, int c) { const int kk = (k & ~0xC) | ((k & 4) << 1) | ((k & 8) >> 1); return ((kk >> 3) * 4 + (c >> 5)) * 512 + ((kk & 7) * 32 + (c & 31)) * 2; }
__device__ __forceinline__ int v_rd_base(int lane) { return ((lane & 3) << 3) | (((lane >> 2) & 3) << 6) | (((lane >> 4) & 1) << 5) | (((lane >> 5) & 1) << 8); }
constexpr int v_rd_off(int d0, int ks, int half) { return d0 * 512 + ks * 4096 + half * 2048; }
__device__ __forceinline__ int crow(int r, int hi) { return (r & 3) + 8 * (r >> 2) + 4 * hi; }
__device__ __forceinline__ float xchg32(float x, int hi) {
    auto rr = __builtin_amdgcn_permlane32_swap(__float_as_uint(x), __float_as_uint(x), false, false);
    return __uint_as_float(hi ? rr[0] : rr[1]);
}
__device__ __forceinline__ void mask_causal(f32x16& p0, f32x16& p1, int dq) {
    const float NEG = -__builtin_inff();
#pragma unroll
    for (int r = 0; r < 16; ++r) {
        const int c = (r & 3) + 8 * (r >> 2);
        if (dq - c < 0) p0[r] = NEG;
        if (dq - c - 32 < 0) p1[r] = NEG;
    }
}
__device__ __forceinline__ void mask_bits(f32x16& p0, f32x16& p1, unsigned lo, unsigned hw, int hi) {
    const float NEG = -__builtin_inff();
    lo >>= 4 * hi; hw >>= 4 * hi;
#pragma unroll
    for (int r = 0; r < 16; ++r) {
        const int c = (r & 3) + 8 * (r >> 2);
        if (((lo >> c) & 1u) == 0u) p0[r] = NEG;
        if (((hw >> c) & 1u) == 0u) p1[r] = NEG;
    }
}
constexpr float ATT_THR = 8.f;
__device__ __forceinline__ void partialSM(f32x16& p0, f32x16& p1, float& m_reg, float& mn, float& alpha, const float scale) {
    float pmax = p0[0];
#pragma unroll
    for (int r = 1; r < 16; ++r) pmax = fmaxf(pmax, p0[r]);
#pragma unroll
    for (int r = 0; r < 16; ++r) pmax = fmaxf(pmax, p1[r]);
    { auto rr = __builtin_amdgcn_permlane32_swap(__float_as_uint(pmax), __float_as_uint(pmax), false, false);
      pmax = fmaxf(__uint_as_float(rr[0]), __uint_as_float(rr[1])); }
    const float C2 = 1.4426950408889634f * scale;
    if (__builtin_expect(__all((pmax - m_reg) * scale <= ATT_THR), 1)) { mn = m_reg; alpha = 1.f; }
    else { mn = fmaxf(m_reg, pmax); alpha = __builtin_amdgcn_exp2f((m_reg - mn) * C2); m_reg = mn; }
    const float mnL = -mn * C2;
#pragma unroll
    for (int r = 0; r < 16; ++r) p0[r] = fmaf(p0[r], C2, mnL);
#pragma unroll
    for (int r = 0; r < 16; ++r) p1[r] = fmaf(p1[r], C2, mnL);
#pragma unroll
    for (int r = 0; r < 16; ++r) p0[r] = __builtin_amdgcn_exp2f(p0[r]);
}
#define PK4(P, B_, OUT) do { unsigned a0 = cvtpk(P[B_+0], P[B_+1]), a1 = cvtpk(P[B_+2], P[B_+3]);                          \
        unsigned b0 = cvtpk(P[B_+4], P[B_+5]), b1 = cvtpk(P[B_+6], P[B_+7]);                                             \
        auto r0 = __builtin_amdgcn_permlane32_swap(a0, b0, false, false); auto r1 = __builtin_amdgcn_permlane32_swap(a1, b1, false, false); \
        u32x4 w = {r0[0], r1[0], r0[1], r1[1]}; OUT = *reinterpret_cast<bf16x8*>(&w); } while (0)
__device__ __forceinline__ void packP(const f32x16& p0, const f32x16& p1, bf16x8& pa0, bf16x8& pa1, bf16x8& pa2, bf16x8& pa3) {
    PK4(p0, 0, pa0); PK4(p0, 8, pa1); PK4(p1, 0, pa2); PK4(p1, 8, pa3);
}
__device__ __forceinline__ void finishSM(f32x16& p0, f32x16& p1, float alpha, float& l_reg, bf16x8& pa0, bf16x8& pa1, bf16x8& pa2, bf16x8& pa3) {
#pragma unroll
    for (int r = 0; r < 16; ++r) p1[r] = __builtin_amdgcn_exp2f(p1[r]);
    float ps = 0;
#pragma unroll
    for (int r = 0; r < 16; ++r) ps += p0[r];
#pragma unroll
    for (int r = 0; r < 16; ++r) ps += p1[r];
    { auto rr = __builtin_amdgcn_permlane32_swap(__float_as_uint(ps), __float_as_uint(ps), false, false);
      ps = __uint_as_float(rr[0]) + __uint_as_float(rr[1]); }
    l_reg = l_reg * alpha + ps;
    packP(p0, p1, pa0, pa1, pa2, pa3);
}
template <int NKD>
__device__ __forceinline__ void qkt(f32x16& p0, f32x16& p1, const LAS unsigned char* K_lds, const LAS unsigned char* KR_lds, int r32, int hi, const bf16x8* qr) {
    p0 = f32x16{}; p1 = f32x16{};
    const LAS unsigned char* kb[4];
#pragma unroll
    for (int dd = 0; dd < 4; ++dd) kb[dd] = K_lds + KSWZ(r32, (dd * 16 + hi * 8) * 2);
#pragma unroll
    for (int d0 = 0; d0 < 8; ++d0) { const LAS unsigned char* a = kb[d0 & 3] + (d0 >> 2) * 128;
        bf16x8 b0 = *(const LAS bf16x8*)(a);
        bf16x8 b1 = *(const LAS bf16x8*)(a + 32 * 256);
        p0 = __builtin_amdgcn_mfma_f32_32x32x16_bf16(b0, qr[d0], p0, 0, 0, 0);
        p1 = __builtin_amdgcn_mfma_f32_32x32x16_bf16(b1, qr[d0], p1, 0, 0, 0); }
    if constexpr (NKD == 12) {
#pragma unroll
        for (int d0 = 0; d0 < 4; ++d0) { const LAS unsigned char* a = KR_lds + r32 * 128 + (((d0 * 16 + hi * 8) * 2) ^ ((r32 & 7) << 4));
            bf16x8 b0 = *(const LAS bf16x8*)(a);
            bf16x8 b1 = *(const LAS bf16x8*)(a + 32 * 128);
            p0 = __builtin_amdgcn_mfma_f32_32x32x16_bf16(b0, qr[8 + d0], p0, 0, 0, 0);
            p1 = __builtin_amdgcn_mfma_f32_32x32x16_bf16(b1, qr[8 + d0], p1, 0, 0, 0); }
    }
}
__device__ __forceinline__ void pv_tile(f32x16* o, int vb0, bf16x8 pa0, bf16x8 pa1, bf16x8 pa2, bf16x8 pa3) {
#define TRRD(dst, off) asm volatile("ds_read_b64_tr_b16 %0, %1 offset:%2" : "=&v"(dst) : "v"(vb0), "i"(off) : "memory")
#define PV_D0(d0) do { s16x4 l0, l1, l2, l3, h0, h1, h2, h3; constexpr int b_ = v_rd_off(d0, 0, 0); \
        TRRD(l0, b_); TRRD(h0, b_ + 2048); TRRD(l1, b_ + 4096); TRRD(h1, b_ + 6144); TRRD(l2, b_ + 8192); TRRD(h2, b_ + 10240); TRRD(l3, b_ + 12288); TRRD(h3, b_ + 14336); \
        asm volatile("s_waitcnt lgkmcnt(0)" ::: "memory"); SBAR();   \
        o[d0] = __builtin_amdgcn_mfma_f32_32x32x16_bf16(pa0, (bf16x8){l0[0], l0[1], l0[2], l0[3], h0[0], h0[1], h0[2], h0[3]}, o[d0], 0, 0, 0);   \
        o[d0] = __builtin_amdgcn_mfma_f32_32x32x16_bf16(pa1, (bf16x8){l1[0], l1[1], l1[2], l1[3], h1[0], h1[1], h1[2], h1[3]}, o[d0], 0, 0, 0);   \
        o[d0] = __builtin_amdgcn_mfma_f32_32x32x16_bf16(pa2, (bf16x8){l2[0], l2[1], l2[2], l2[3], h2[0], h2[1], h2[2], h2[3]}, o[d0], 0, 0, 0);   \
        o[d0] = __builtin_amdgcn_mfma_f32_32x32x16_bf16(pa3, (bf16x8){l3[0], l3[1], l3[2], l3[3], h3[0], h3[1], h3[2], h3[3]}, o[d0], 0, 0, 0); } while (0)
    PV_D0(0); PV_D0(1); PV_D0(2); PV_D0(3);
#undef PV_D0
#undef TRRD
}

struct AttnWave {
    const bf16_t* Q; int ldq;
    const float* cs;
    const bf16_t* K; int ldk;
    const bf16_t* KR; int ldkr;
    const bf16_t* V; int ldv;
    const unsigned long long* mw;
    bf16_t* O; int ldo;
    const float* gout;
    int qlo;
    int nt_w;
};
__device__ __forceinline__ void attn_store(const f32x16* o, LAS float* ws, const AttnWave& A, int r32, int hi, bool use_l, float l_reg) {
    LAS float* li_l = ws;
    asm volatile("" : "+v"(r32), "+v"(hi));
    if (use_l) { if (hi == 0) li_l[r32] = l_reg; LDS_WAIT(); }
    float gv[4];
#pragma unroll
    for (int d0 = 0; d0 < 4; ++d0) gv[d0] = A.gout[d0 * 32 + r32];
#pragma unroll
    for (int r = 0; r < 16; ++r) {
        const int orow = crow(r, hi);
        const float il = use_l ? __builtin_amdgcn_rcpf(li_l[orow]) : 1.f;
        float v[4]; float ss = 0.f;
#pragma unroll
        for (int d0 = 0; d0 < 4; ++d0) { v[d0] = o[d0][r] * il; ss += v[d0] * v[d0]; }
        ss += __shfl_xor(ss, 1); ss += __shfl_xor(ss, 2); ss += __shfl_xor(ss, 4); ss += __shfl_xor(ss, 8); ss += __shfl_xor(ss, 16);
        const float rs = rsqrtf(ss * (1.f / 128.f) + EPS);
#pragma unroll
        for (int d0 = 0; d0 < 4; ++d0) { const float y = v[d0] * rs * gv[d0];
            if (WO_FP8) { const float y1 = __shfl_xor(y, 1), y2 = __shfl_xor(y, 2), y3 = __shfl_xor(y, 3);
                if ((r32 & 3) == 0) *(unsigned*)((unsigned char*)A.O + (size_t)orow * A.ldo + d0 * 32 + r32) = pk4_fp8(y, y1, y2, y3); }
            else { const float yn = __shfl_xor(y, 1);
                if ((r32 & 1) == 0) *(unsigned*)(A.O + (size_t)orow * A.ldo + d0 * 32 + r32) = cvtpk(y, yn); } }
    }
}
constexpr int ATT_BUF = SHM_V + SHM_K + SHM_KR;
constexpr int ATT_WS2 = 2 * ATT_BUF;
template <bool HASKR>
struct TileDma {
    unsigned ko[2], vo[2], kro;
    __device__ __forceinline__ void init(const AttnWave& A, int wid, int lane) {
#pragma unroll
        for (int j = 0; j < 2; ++j) {
            const int p = (wid * 2 + j) * 64 + lane;
            { const int row = p >> 4, ch = (p & 15) ^ (row & 7); ko[j] = (unsigned)(row * A.ldk + ch * 8) * 2u; }
            { const int sub = p >> 5, q = p & 31, kk = (sub >> 2) * 8 + (q >> 2), c = (sub & 3) * 32 + (q & 3) * 8;
              const int k = (kk & ~0xC) | ((kk & 4) << 1) | ((kk & 8) >> 1); vo[j] = (unsigned)(k * A.ldv + c) * 2u; }
        }
        if constexpr (HASKR) { const int p = wid * 64 + lane, row = p >> 3, ch = (p & 7) ^ (row & 7); kro = (unsigned)(row * A.ldkr + ch * 8) * 2u; } else kro = 0u;
    }
    __device__ __forceinline__ void issue_at(LAS unsigned char* ldsl, int boff, const AttnWave& A, int kb, int wid) const {
        const char* kbase = (const char*)A.K + (size_t)kb * A.ldk * 2; const char* vbase = (const char*)A.V + (size_t)kb * A.ldv * 2;
#pragma unroll
        for (int j = 0; j < 2; ++j) {
            __builtin_amdgcn_global_load_lds((const unsigned*)(kbase + ko[j]), (LAS unsigned*)(ldsl + boff + ATT_K + (wid * 2 + j) * 1024), 16, 0, 0);
            __builtin_amdgcn_global_load_lds((const unsigned*)(vbase + vo[j]), (LAS unsigned*)(ldsl + boff + ATT_V + (wid * 2 + j) * 1024), 16, 0, 0);
        }
        if constexpr (HASKR) { const char* rbase = (const char*)A.KR + (size_t)kb * A.ldkr * 2;
            __builtin_amdgcn_global_load_lds((const unsigned*)(rbase + kro), (LAS unsigned*)(ldsl + boff + ATT_KR + wid * 1024), 16, 0, 0); }
    }
};

template <int MODE>
__device__ __forceinline__ void attn_softmax_block(LAS unsigned char* ldsl, const int tid, const AttnWave& A, int nt_wg, float scale) {
    constexpr bool MLA = (MODE == 0); constexpr int NKD = MLA ? 12 : 8;
    const int wid = __builtin_amdgcn_readfirstlane(tid >> 6), lane = tid & 63, r32 = lane & 31, hi = lane >> 5;
    LAS float* ws = (LAS float*)(ldsl + 3 * ATT_BUF) + wid * 64; LAS float* al_l = ws + 32;
    bf16x8 qr[NKD];
#pragma unroll
    for (int d0 = 0; d0 < NKD; ++d0) qr[d0] = *(const bf16x8*)(A.Q + (size_t)r32 * A.ldq + d0 * 16 + hi * 8);
    if constexpr (MLA) {
#pragma unroll
        for (int dd = 0; dd < 2; ++dd) {
            bf16x8 x1 = qr[8 + dd], x2 = qr[10 + dd];
#pragma unroll
            for (int j = 0; j < 8; ++j) { const int i = dd * 16 + hi * 8 + j; const f32x2 c = *(const f32x2*)(A.cs + (size_t)r32 * 64 + 2 * i);
                const float a = bf2f((unsigned short)x1[j]), b = bf2f((unsigned short)x2[j]);
                x1[j] = (short)f2bf(a * c[0] - b * c[1]); x2[j] = (short)f2bf(b * c[0] + a * c[1]); }
            qr[8 + dd] = x1; qr[10 + dd] = x2;
        }
    }
    float m_reg = -1e30f, l_reg = 0.f; f32x16 o[4] = {};
    const int vbase = (int)(unsigned)(uintptr_t)(ldsl + ATT_V) + v_rd_base(lane);
    const int qm = A.qlo + r32 - 4 * hi;
    TileDma<MLA> dma; dma.init(A, wid, lane);
    constexpr int TB = MLA ? ATT_BUF : (SHM_V + SHM_K), NP = MLA ? 5 : 4;
    LAS unsigned long long* maskl = (LAS unsigned long long*)(ldsl + 3 * (SHM_V + SHM_K)) + (wid >> 2) * 1024;
    if constexpr (MODE == 2) {
        const int tg = (wid & 3) * 64 + lane;
#pragma unroll
        for (int j = 0; j < 4; ++j) maskl[tg + 256 * j] = A.mw[tg + 256 * j];
        __syncthreads();
    }
    dma.issue_at(ldsl, 0, A, 0, wid); if (nt_wg > 1) dma.issue_at(ldsl, TB, A, 64, wid);
    if (wid < 4) __builtin_amdgcn_s_setprio(2); else __builtin_amdgcn_s_setprio(0);
    int bcur = 0;
    for (int t = 0; t < nt_wg; ++t) {
        const int kb = t * 64;
        if (t + 1 < nt_wg) { if constexpr (MLA) asm volatile("s_waitcnt vmcnt(5)" ::: "memory"); else asm volatile("s_waitcnt vmcnt(4)" ::: "memory"); } else VM_WAIT();
        asm volatile("s_waitcnt lgkmcnt(0)" ::: "memory"); __builtin_amdgcn_s_barrier(); asm volatile("" ::: "memory");
        const int bfree = (bcur == 0) ? 2 : bcur - 1;
        if (t + 2 < nt_wg) dma.issue_at(ldsl, bfree * TB, A, kb + 128, wid);
        if (t < A.nt_w) {
            f32x16 p0, p1; float mn, al; bf16x8 pa0, pa1, pa2, pa3;
            const int vb0 = vbase + bcur * TB;
            qkt<NKD>(p0, p1, ldsl + bcur * TB + ATT_K, ldsl + bcur * TB + ATT_KR, r32, hi, qr);
            if constexpr (MODE == 2) { const unsigned long long mw_cur = maskl[r32 * 32 + t]; mask_bits(p0, p1, (unsigned)mw_cur, (unsigned)(mw_cur >> 32), hi); }
            else { if (kb + 63 > A.qlo) mask_causal(p0, p1, qm - kb); }
            partialSM(p0, p1, m_reg, mn, al, scale);
            if (__any(al < 1.f)) { if (hi == 0) al_l[r32] = al; LDS_WAIT();
#pragma unroll
                for (int d = 0; d < 4; ++d)
#pragma unroll
                    for (int r = 0; r < 16; ++r) o[d][r] *= al_l[crow(r, hi)]; }
            finishSM(p0, p1, al, l_reg, pa0, pa1, pa2, pa3);
            pv_tile(o, vb0, pa0, pa1, pa2, pa3);
        }
        bcur = (bcur == 2) ? 0 : bcur + 1;
    }
    __builtin_amdgcn_s_setprio(0);
    attn_store(o, ws, A, r32, hi, true, l_reg);
    __syncthreads();
}

constexpr int DSA_TB = 32768;
__device__ __forceinline__ void attn_dsa_block(LAS unsigned char* ldsl, const int tid, const AttnWave& A, int nt, float scale) {
    const int wid = __builtin_amdgcn_readfirstlane(tid >> 6), lane = tid & 63, r32 = lane & 31, hi = lane >> 5, grp = wid >> 2, head = wid & 3;
    LAS float* ws = (LAS float*)(ldsl + 4 * DSA_TB + 8192) + wid * 64; LAS float* al_l = ws + 32;
    LAS unsigned long long* maskl = (LAS unsigned long long*)(ldsl + 4 * DSA_TB);
    { const int tg = wid * 64 + lane; maskl[tg] = A.mw[tg]; maskl[tg + 512] = A.mw[tg + 512]; }
    bf16x8 qr[8];
#pragma unroll
    for (int d0 = 0; d0 < 8; ++d0) qr[d0] = *(const bf16x8*)(A.Q + (size_t)r32 * A.ldq + d0 * 16 + hi * 8);
    float m_reg = -1e30f, l_reg = 0.f; f32x16 o[4] = {};
    const int vbase = (int)(unsigned)(uintptr_t)(ldsl + ATT_V) + v_rd_base(lane);
    TileDma<false> dma; dma.init(A, wid, lane);
    const int nticks = (nt + 1) >> 1;
    dma.issue_at(ldsl, 0, A, 0, wid); if (nt > 1) dma.issue_at(ldsl, DSA_TB, A, 64, wid);
    for (int s = 0; s < nticks; ++s) {
        const int pair = (s & 1) * 2 * DSA_TB;
        VM_WAIT(); __syncthreads();
        if (s + 1 < nticks) { const int np = pair ^ (2 * DSA_TB); dma.issue_at(ldsl, np, A, (2 * s + 2) * 64, wid); if (2 * s + 3 < nt) dma.issue_at(ldsl, np + DSA_TB, A, (2 * s + 3) * 64, wid); }
        const int t = 2 * s + grp;
        if (t < nt) {
            f32x16 p0, p1; float mn, al; bf16x8 pa0, pa1, pa2, pa3;
            const int boff = pair + grp * DSA_TB;
            qkt<8>(p0, p1, ldsl + boff + ATT_K, ldsl + boff + ATT_K, r32, hi, qr);
            { const unsigned long long w = maskl[r32 * 32 + t]; mask_bits(p0, p1, (unsigned)w, (unsigned)(w >> 32), hi); }
            partialSM(p0, p1, m_reg, mn, al, scale);
            if (__any(al < 1.f)) { if (hi == 0) al_l[r32] = al; LDS_WAIT();
#pragma unroll
                for (int d = 0; d < 4; ++d)
#pragma unroll
                    for (int r = 0; r < 16; ++r) o[d][r] *= al_l[crow(r, hi)]; }
            finishSM(p0, p1, al, l_reg, pa0, pa1, pa2, pa3);
            pv_tile(o, vbase + boff, pa0, pa1, pa2, pa3);
        }
    }
    __syncthreads();
    LAS float* xo = (LAS float*)ldsl + head * 4096;
    LAS float* xm = (LAS float*)(ldsl + 65536) + head * 128;
    if (grp == 1) {
#pragma unroll
        for (int d = 0; d < 4; ++d)
#pragma unroll
            for (int r = 0; r < 16; ++r) xo[(d * 16 + r) * 64 + lane] = o[d][r];
        xm[lane] = m_reg; xm[64 + lane] = l_reg;
    }
    __syncthreads();
    if (grp == 0) {
        const float m1 = xm[lane], l1 = xm[64 + lane];
        const float C2 = 1.4426950408889634f * scale;
        const float mm = fmaxf(m_reg, m1), a0 = __builtin_amdgcn_exp2f((m_reg - mm) * C2), a1 = __builtin_amdgcn_exp2f((m1 - mm) * C2);
        l_reg = l_reg * a0 + l1 * a1;
        if (hi == 0) al_l[r32] = a0; LDS_WAIT();
#pragma unroll
        for (int d = 0; d < 4; ++d)
#pragma unroll
            for (int r = 0; r < 16; ++r) o[d][r] *= al_l[crow(r, hi)];
        LDS_WAIT();
        if (hi == 0) al_l[r32] = a1; LDS_WAIT();
#pragma unroll
        for (int d = 0; d < 4; ++d)
#pragma unroll
            for (int r = 0; r < 16; ++r) o[d][r] = fmaf(xo[(d * 16 + r) * 64 + lane], al_l[crow(r, hi)], o[d][r]);
        attn_store(o, ws, A, r32, hi, true, l_reg);
    }
    __syncthreads();
}

__device__ __forceinline__ void attn_sb_block(LAS unsigned char* ldsl, const int tid, const AttnWave& A, int nt_wg, float scale) {
    const int wid = __builtin_amdgcn_readfirstlane(tid >> 6), lane = tid & 63, r32 = lane & 31, hi = lane >> 5;
    LAS float* ws = (LAS float*)(ldsl + 3 * ATT_BUF) + wid * 64;
    bf16x8 qr[8];
#pragma unroll
    for (int d0 = 0; d0 < 8; ++d0) qr[d0] = *(const bf16x8*)(A.Q + (size_t)r32 * A.ldq + d0 * 16 + hi * 8);
    float carry = 0.f; f32x16 o[4] = {};
    const int vbase = (int)(unsigned)(uintptr_t)(ldsl + ATT_V) + v_rd_base(lane);
    const int qm = A.qlo + r32 - 4 * hi;
    LAS int* wflag = (LAS int*)(ldsl + 3 * ATT_BUF + 2048);
    bool wdone = false;
    if (lane == 0) wflag[wid] = 0;
    TileDma<false> dma; dma.init(A, wid, lane);
    constexpr int TB = SHM_V + SHM_K;
    dma.issue_at(ldsl, 0, A, (nt_wg - 1) * 64, wid); if (nt_wg > 1) dma.issue_at(ldsl, TB, A, (nt_wg - 2) * 64, wid);
    int bcur = 0;
    for (int t = nt_wg - 1; t >= 0; --t, bcur = (bcur == 2) ? 0 : bcur + 1) {
        const int kb = t * 64;
        if (t > 0) asm volatile("s_waitcnt vmcnt(4)" ::: "memory"); else VM_WAIT();
        asm volatile("s_waitcnt lgkmcnt(0)" ::: "memory"); __builtin_amdgcn_s_barrier(); asm volatile("" ::: "memory");
        { const u32x4 f0 = *(const LAS u32x4*)wflag, f1 = *(const LAS u32x4*)(wflag + 4);
          if ((f0.x & f0.y & f0.z & f0.w & f1.x & f1.y & f1.z & f1.w) != 0u) break; }
        { const int bfree = (bcur == 0) ? 2 : bcur - 1; if (t >= 2) dma.issue_at(ldsl, bfree * TB, A, kb - 128, wid); }
        if (t < A.nt_w && !wdone) {
            f32x16 p0, p1, L0, L1; bf16x8 pa0, pa1, pa2, pa3;
            const int vb0 = vbase + bcur * TB;
            qkt<8>(p0, p1, ldsl + bcur * TB + ATT_K, ldsl + bcur * TB + ATT_K, r32, hi, qr);
            const int dq = qm - kb;
#pragma unroll
            for (int r = 0; r < 16; ++r) { const int c = (r & 3) + 8 * (r >> 2);
                { const float z = p0[r] * scale; const float sp = __builtin_amdgcn_logf(1.f + __builtin_amdgcn_exp2f(-fabsf(z) * 1.4426950408889634f)) * 0.6931471805599453f;
                  const float ls = fminf(z, 0.f) - sp; p0[r] = ls; L0[r] = (dq - c > 0) ? (ls - z) : 0.f; }
                { const float z = p1[r] * scale; const float sp = __builtin_amdgcn_logf(1.f + __builtin_amdgcn_exp2f(-fabsf(z) * 1.4426950408889634f)) * 0.6931471805599453f;
                  const float ls = fminf(z, 0.f) - sp; p1[r] = ls; L1[r] = (dq - c - 32 > 0) ? (ls - z) : 0.f; } }
            float gs[8], pg[8], after[8];
#pragma unroll
            for (int g = 0; g < 4; ++g) { gs[g] = (L0[4 * g] + L0[4 * g + 1]) + (L0[4 * g + 2] + L0[4 * g + 3]); gs[4 + g] = (L1[4 * g] + L1[4 * g + 1]) + (L1[4 * g + 2] + L1[4 * g + 3]); }
#pragma unroll
            for (int g = 0; g < 8; ++g) pg[g] = xchg32(gs[g], hi);
            float run = 0.f;
#pragma unroll
            for (int g = 7; g >= 0; --g) { after[g] = run + (hi == 0 ? pg[g] : 0.f); run += gs[g] + pg[g]; }
#pragma unroll
            for (int g = 0; g < 4; ++g) {
                { const float s3 = after[g] + carry, s2 = s3 + L0[4 * g + 3], s1 = s2 + L0[4 * g + 2], s0 = s1 + L0[4 * g + 1];
                  const int c = 8 * g;
                  p0[4 * g + 0] = (dq - (c + 0) > 0) ? __expf(p0[4 * g + 0] + s0) : 0.f; p0[4 * g + 1] = (dq - (c + 1) > 0) ? __expf(p0[4 * g + 1] + s1) : 0.f;
                  p0[4 * g + 2] = (dq - (c + 2) > 0) ? __expf(p0[4 * g + 2] + s2) : 0.f; p0[4 * g + 3] = (dq - (c + 3) > 0) ? __expf(p0[4 * g + 3] + s3) : 0.f; }
                { const float s3 = after[4 + g] + carry, s2 = s3 + L1[4 * g + 3], s1 = s2 + L1[4 * g + 2], s0 = s1 + L1[4 * g + 1];
                  const int c = 8 * g + 32;
                  p1[4 * g + 0] = (dq - (c + 0) > 0) ? __expf(p1[4 * g + 0] + s0) : 0.f; p1[4 * g + 1] = (dq - (c + 1) > 0) ? __expf(p1[4 * g + 1] + s1) : 0.f;
                  p1[4 * g + 2] = (dq - (c + 2) > 0) ? __expf(p1[4 * g + 2] + s2) : 0.f; p1[4 * g + 3] = (dq - (c + 3) > 0) ? __expf(p1[4 * g + 3] + s3) : 0.f; }
            }
            carry += run;
            packP(p0, p1, pa0, pa1, pa2, pa3);
            pv_tile(o, vb0, pa0, pa1, pa2, pa3);
            if (__all(carry < -105.f)) { wdone = true; if (lane == 0) wflag[wid] = 1; }
        }
    }
    attn_store(o, ws, A, r32, hi, false, 1.f);
    __syncthreads();
}


constexpr int IXQ_LD = 2064;
constexpr int IXQ_TILE = 32 * IXQ_LD + 2048;
__device__ __forceinline__ void indexer_pair(const Ctx& C, int b, int i) {
    const bf16_t* proj = (const bf16_t*)(C.ws + WS_PROJ); float* scores = (float*)(C.ws + WS_SC);
    const int tid = C.tid, lane = C.lane, wid = C.wave, r32 = lane & 31, hi = lane >> 5;
    __syncthreads();
    {
        u32x4 tq[2][8]; float wq[2];
#pragma unroll
        for (int blk = 0; blk < 2; ++blk) {
            const size_t trow0 = (size_t)b * SEQ + (blk ? i : 63 - i) * 32;
#pragma unroll
            for (int j = 0; j < 8; ++j) { const int ch = tid + 512 * j, row = ch >> 7, c = ch & 127; tq[blk][j] = *(const u32x4*)(proj + (trow0 + row) * NPROJ + O_IXQ + c * 8); }
            wq[blk] = bf2f(proj[(trow0 + (tid >> 4)) * NPROJ + O_IXW + (tid & 15)]) * 0.03125f;
        }
#pragma unroll
        for (int blk = 0; blk < 2; ++blk) {
#pragma unroll
            for (int j = 0; j < 8; ++j) { const int ch = tid + 512 * j, row = ch >> 7, c = ch & 127; *(LAS u32x4*)(C.ldsl + blk * IXQ_TILE + row * IXQ_LD + c * 16) = tq[blk][j]; }
            ((LAS float*)(C.ldsl + blk * IXQ_TILE + 32 * IXQ_LD))[tid] = wq[blk];
        }
    }
    __syncthreads();
    const int ntB = ((63 - i) * 32 + 31) / 64 + 1, ntA = (i * 32 + 31) / 64 + 1, ntot = ntB + ntA;
    const bf16_t* kix = proj + (size_t)b * SEQ * NPROJ + O_IXK;
    bf16x8 kf[2][4], kn[2][4];
    { const int kb = ((wid < ntB) ? wid : wid - ntB) * 64;
      if (wid < ntot) {
#pragma unroll
        for (int hf = 0; hf < 2; ++hf)
#pragma unroll
            for (int ks = 0; ks < 4; ++ks) kn[hf][ks] = *(const bf16x8*)(kix + (size_t)(kb + hf * 32 + r32) * NPROJ + ks * 16 + hi * 8); } }
    for (int it = wid; it < ntot; it += NWAVES) {
        const int blk = (it < ntB) ? 0 : 1, t = blk ? it - ntB : it, kb = t * 64;
#pragma unroll
        for (int hf = 0; hf < 2; ++hf)
#pragma unroll
            for (int ks = 0; ks < 4; ++ks) kf[hf][ks] = kn[hf][ks];
        const int itn = it + NWAVES;
        if (itn < ntot) { const int kbn = ((itn < ntB) ? itn : itn - ntB) * 64;
#pragma unroll
            for (int hf = 0; hf < 2; ++hf)
#pragma unroll
                for (int ks = 0; ks < 4; ++ks) kn[hf][ks] = *(const bf16x8*)(kix + (size_t)(kbn + hf * 32 + r32) * NPROJ + ks * 16 + hi * 8); }
        const LAS unsigned char* qt = C.ldsl + blk * IXQ_TILE + r32 * IXQ_LD + hi * 16;
        const LAS float* wt = (const LAS float*)(C.ldsl + blk * IXQ_TILE + 32 * IXQ_LD) + r32 * 16;
        f32x16 a0 = {}, a1 = {}, sA0 = {}, sA1 = {}, sB0, sB1;
#define IX_MMA(S0, S1, h) do { _Pragma("unroll") for (int ks = 0; ks < 4; ++ks) { const bf16x8 qf = *(const LAS bf16x8*)(qt + (h) * 128 + ks * 32); \
            S0 = __builtin_amdgcn_mfma_f32_32x32x16_bf16(kf[0][ks], qf, S0, 0, 0, 0); S1 = __builtin_amdgcn_mfma_f32_32x32x16_bf16(kf[1][ks], qf, S1, 0, 0, 0); } } while (0)
#define IX_RELU(x) __int_as_float(max(__float_as_int(x), 0))
#define IX_ACC(S0, S1, h) do { const float w_ = wt[h]; _Pragma("unroll") for (int r = 0; r < 16; ++r) { a0[r] = fmaf(w_, IX_RELU(S0[r]), a0[r]); a1[r] = fmaf(w_, IX_RELU(S1[r]), a1[r]); } } while (0)
        IX_MMA(sA0, sA1, 0);
#pragma unroll 1
        for (int h = 0; h < 16; h += 2) {
            sB0 = f32x16{}; sB1 = f32x16{}; IX_MMA(sB0, sB1, h + 1);
            IX_ACC(sA0, sA1, h);
            sA0 = f32x16{}; sA1 = f32x16{}; if (h + 2 < 16) IX_MMA(sA0, sA1, h + 2);
            IX_ACC(sB0, sB1, h + 1);
        }
#undef IX_MMA
#undef IX_ACC
        const size_t trow0 = (size_t)b * SEQ + (blk ? i : 63 - i) * 32;
        float* srow = scores + (trow0 + r32) * SEQ + kb + 4 * hi;
#pragma unroll
        for (int g = 0; g < 4; ++g) { *(f32x4*)(srow + 8 * g) = (f32x4){a0[4 * g], a0[4 * g + 1], a0[4 * g + 2], a0[4 * g + 3]};
                                      *(f32x4*)(srow + 32 + 8 * g) = (f32x4){a1[4 * g], a1[4 * g + 1], a1[4 * g + 2], a1[4 * g + 3]}; }
    }
}
__device__ __forceinline__ void phase_indexer(const Ctx& C) {
    for (int it = C.bid; it < NB * 32; it += C.G) indexer_pair(C, it >> 5, it & 31);
    __syncthreads();
}

template <int NR>
__device__ __forceinline__ int sel_count_ge(const unsigned (&u)[NR], unsigned trial) {
    int c = 0;
#pragma unroll
    for (int j = 0; j < NR; ++j) asm volatile("v_cmp_le_u32 vcc, %1, %2\n\tv_addc_co_u32 %0, vcc, 0, %0, vcc" : "+v"(c) : "s"(trial), "v"(u[j]) : "vcc");
    int tot = 0;
#pragma unroll
    for (int b = 0; b < 6; ++b) tot += __popcll(__ballot((c >> b) & 1)) << b;
    return tot;
}
template <int NR>
__device__ __forceinline__ unsigned long long sel_row(const float* srow, int qpos, int lane, LAS unsigned* scr) {
    const int ntile = (qpos >> 6) + 1;
    unsigned u[NR];
#pragma unroll
    for (int j = 0; j < NR; ++j) { const int key = j * 64 + lane; unsigned v = 0u;
        if (j < ntile) { const unsigned bits = __float_as_uint(srow[key]); v = (key <= qpos) ? (bits ^ ((bits >> 31) ? 0xFFFFFFFFu : 0x80000000u)) : 0u; }
        u[j] = v; }
    unsigned long long myword = 0ull;
    unsigned prefix = 0u; int clo = qpos + 1, chi = 0, bit = 31;
#pragma unroll 1
    for (; bit >= 0; --bit) {
        const unsigned trial = prefix | (1u << bit); const int cnt = sel_count_ge<NR>(u, trial);
        if (cnt >= 256) { prefix = trial; clo = cnt; } else { chi = cnt; }
        if (clo - chi <= 64) break;
    }
    if (bit > 0) {
        const unsigned span = 1u << bit; const int need0 = 256 - chi;
        int slot = 0;
#pragma unroll
        for (int j = 0; j < NR; ++j) { const bool in = (u[j] - prefix) < span && u[j] != 0u; const unsigned long long m = __ballot(in);
            if (m != 0ull) { const int pos = slot + __popcll(m & ((1ull << lane) - 1ull)); if (in && pos < 64) scr[pos] = u[j]; slot += __popcll(m); } }
        LDS_WAIT();
        const unsigned c = (lane < slot) ? scr[lane] : 0u;
#pragma unroll 1
        for (int b2 = bit - 1; b2 >= 0; --b2) { const unsigned trial = prefix | (1u << b2); const int cnt = __popcll(__ballot(c >= trial)); if (cnt >= need0) prefix = trial; }
    }
    int tot = 0; unsigned long long gew[NR];
#pragma unroll
    for (int j = 0; j < NR; ++j) { gew[j] = __ballot(u[j] >= prefix); tot += __popcll(gew[j]); }
    if (tot == 256) {
#pragma unroll
        for (int j = 0; j < NR; ++j) myword = (lane == j) ? gew[j] : myword;
    } else {
        int ngt = 0;
#pragma unroll
        for (int j = 0; j < NR; ++j) ngt += __popcll(__ballot(u[j] > prefix));
        int need = 256 - ngt;
#pragma unroll
        for (int j = 0; j < NR; ++j) {
            const unsigned long long gt = __ballot(u[j] > prefix); unsigned long long eq = __ballot(u[j] == prefix);
            int ne = __popcll(eq);
            if (ne > need) { while (ne > need) { eq &= ~(1ull << (63 - __clzll(eq))); --ne; } }
            need -= ne;
            const unsigned long long m = gt | eq; myword = (lane == j) ? m : myword;
        }
    }
    return myword;
}
__device__ __forceinline__ void phase_select(const Ctx& C) {
    const float* scores = (const float*)(C.ws + WS_SC); unsigned long long* mask = (unsigned long long*)(C.ws + WS_MASK);
    const int lane = C.lane;
    LAS unsigned* scr = (LAS unsigned*)(C.ldsl + 96 * 1024 + C.wave * 256);
    for (int t0 = C.gw, it = 0; t0 < T; t0 += C.NGW, ++it) {
        const int t = (it & 1) ? ((t0 & ~(SEQ - 1)) | (SEQ - 1 - (t0 & (SEQ - 1)))) : t0;
        const int qpos = t & (SEQ - 1);
        const float* srow = scores + (size_t)t * SEQ;
        unsigned long long myword = 0ull;
        if (qpos < 256) {
#pragma unroll
            for (int j = 0; j < 4; ++j) { const int key = j * 64 + lane; const unsigned long long m = __ballot(key <= qpos); myword = (lane == j) ? m : myword; }
        } else if (qpos < 512) myword = sel_row<8>(srow, qpos, lane, scr);
        else if (qpos < 768) myword = sel_row<12>(srow, qpos, lane, scr);
        else if (qpos < 1024) myword = sel_row<16>(srow, qpos, lane, scr);
        else if (qpos < 1280) myword = sel_row<20>(srow, qpos, lane, scr);
        else if (qpos < 1536) myword = sel_row<24>(srow, qpos, lane, scr);
        else if (qpos < 1792) myword = sel_row<28>(srow, qpos, lane, scr);
        else myword = sel_row<32>(srow, qpos, lane, scr);
        if (lane < 32) mask[(size_t)t * 32 + lane] = myword;
    }
}

constexpr int RT_LD = 4112;
__device__ __forceinline__ void phase_router(const Ctx& C, int l, const bf16_t* x1, bool commit = true) {
    const float* g = C.ap->in[I_NFG] + (size_t)l * DM; const float* mod = (const float*)(C.ws + WS_MOD) + (size_t)l * NB * 6 * DM;
    const float* msh = mod + 3 * DM; const float* msc = mod + 4 * DM;
    bf16_t* h2 = (bf16_t*)(C.ws + WS_H); unsigned char* h2f8 = C.ws + WS_H8;
    const bf16_t* WrT = (const bf16_t*)(C.ws + WS_W + (size_t)l * LW_BYTES + LW_R);
    const float* brt = C.ap->in[I_BR] + (size_t)l * NE;
    unsigned* gcnt = (unsigned*)(C.ws + WS_CTL) + CW_CNT + l * 64;
    int* rte = (int*)(C.ws + WS_RTE); int* rts = (int*)(C.ws + WS_RTS); float* rtg = (float*)(C.ws + WS_RTG); int* slot_tok = (int*)(C.ws + WS_ST);
    const int tid = C.tid, lane = C.lane, wid = C.wave, r32 = lane & 31, hi = lane >> 5;
    LAS float* part = (LAS float*)C.ldsl;
    LAS float* logit = (LAS float*)(C.ldsl + 65536);
    LAS float* work = (LAS float*)(C.ldsl + 65536 + 8192);
    LAS int* lcnt = (LAS int*)(C.ldsl + 136 * 1024);
    LAS int* lbase = lcnt + 64;
    for (int tile = C.bid; tile < T / 32; tile += C.G) {
        const int tok0 = tile * 32, b = tok0 / SEQ;
        __syncthreads();
        {
            f32x4 a[4][2], s[4][2];
#pragma unroll
            for (int j = 0; j < 4; ++j)
#pragma unroll
                for (int q = 0; q < 2; ++q) { const int col = 8 * lane + 512 * j + 4 * q; const f32x4 gg = *(const f32x4*)(g + col), sc = *(const f32x4*)(msc + (size_t)b * 6 * DM + col);
                    a[j][q] = gg * (sc + 1.f); s[j][q] = *(const f32x4*)(msh + (size_t)b * 6 * DM + col); }
            u32x4 xw[4][4];
#pragma unroll
            for (int r = 0; r < 4; ++r)
#pragma unroll
                for (int j = 0; j < 4; ++j) xw[r][j] = *(const u32x4*)(x1 + (size_t)(tok0 + wid * 4 + r) * DM + 8 * lane + 512 * j);
#pragma unroll
            for (int r = 0; r < 4; ++r) {
                const int row = wid * 4 + r;
                f32x4 v[4][2]; float ss = 0.f;
#pragma unroll
                for (int j = 0; j < 4; ++j) { v[j][0] = (f32x4){bflo(xw[r][j].x), bfhi(xw[r][j].x), bflo(xw[r][j].y), bfhi(xw[r][j].y)}; v[j][1] = (f32x4){bflo(xw[r][j].z), bfhi(xw[r][j].z), bflo(xw[r][j].w), bfhi(xw[r][j].w)};
                    ss += ((v[j][0][0] * v[j][0][0] + v[j][0][1] * v[j][0][1]) + (v[j][0][2] * v[j][0][2] + v[j][0][3] * v[j][0][3])) + ((v[j][1][0] * v[j][1][0] + v[j][1][1] * v[j][1][1]) + (v[j][1][2] * v[j][1][2] + v[j][1][3] * v[j][1][3])); }
                const float rstd = rsqrtf(wave_sum(ss) * (1.f / DM) + EPS);
                bf16_t* hr = h2 + (size_t)(tok0 + row) * DM;
#pragma unroll
                for (int j = 0; j < 4; ++j) { const f32x4 y0 = v[j][0] * rstd * a[j][0] + s[j][0], y1 = v[j][1] * rstd * a[j][1] + s[j][1];
                    u32x4 w; w.x = cvtpk(y0[0], y0[1]); w.y = cvtpk(y0[2], y0[3]); w.z = cvtpk(y1[0], y1[1]); w.w = cvtpk(y1[2], y1[3]);
                    if (!SH_FP8) *(u32x4*)(hr + 8 * lane + 512 * j) = w;
                    *(LAS u32x4*)(C.ldsl + row * RT_LD + (8 * lane + 512 * j) * 2) = w;
                    u32x2 w8; w8.x = pk4_fp8(y0[0], y0[1], y0[2], y0[3]); w8.y = pk4_fp8(y1[0], y1[1], y1[2], y1[3]);
                    *(u32x2*)(h2f8 + (size_t)(tok0 + row) * DM + 8 * lane + 512 * j) = w8; }
            }
        }
        if (tid < 64) lcnt[tid] = 0;
        __syncthreads();
        f32x16 acc0 = {}, acc1 = {};
        {
            const int kw = wid * 256;
#pragma unroll 8
            for (int ks = 0; ks < 16; ++ks) {
                const bf16x8 af = *(const LAS bf16x8*)(C.ldsl + r32 * RT_LD + (kw + ks * 16 + hi * 8) * 2);
                const bf16x8 b0 = *(const bf16x8*)(WrT + (size_t)r32 * DM + kw + ks * 16 + hi * 8);
                const bf16x8 b1 = *(const bf16x8*)(WrT + (size_t)(32 + r32) * DM + kw + ks * 16 + hi * 8);
                acc0 = __builtin_amdgcn_mfma_f32_32x32x16_bf16(af, b0, acc0, 0, 0, 0);
                acc1 = __builtin_amdgcn_mfma_f32_32x32x16_bf16(af, b1, acc1, 0, 0, 0);
            }
        }
        __syncthreads();
#pragma unroll
        for (int r = 0; r < 16; ++r) { const int tk = crow(r, hi); part[(wid * 32 + tk) * 64 + r32] = acc0[r]; part[(wid * 32 + tk) * 64 + 32 + r32] = acc1[r]; }
        __syncthreads();
#pragma unroll
        for (int j = 0; j < 4; ++j) { const int idx = tid + 512 * j; float sacc = 0.f;
#pragma unroll
            for (int w = 0; w < 8; ++w) sacc += part[w * 2048 + idx];
            logit[idx] = sacc; }
        __syncthreads();
        if (!commit) continue;
        int rk[4], sl[4]; float gk[4];
        const float bias_e = brt[lane];
#pragma unroll
        for (int q = 0; q < 4; ++q) {
            const int tk = wid * 4 + q;
            const float sg = 1.f / (1.f + __expf(-logit[tk * 64 + lane])); const float bv = sg + bias_e;
            float m1 = bv; m1 = fmaxf(m1, __shfl_xor(m1, 1)); m1 = fmaxf(m1, __shfl_xor(m1, 2)); m1 = fmaxf(m1, __shfl_xor(m1, 4));
            const unsigned long long eqm = __ballot(bv == m1) >> (lane & ~7);
            const int first = __ffsll((long long)(eqm & 0xffull)) - 1;
            float m2 = ((lane & 7) == first) ? -__builtin_inff() : bv; m2 = fmaxf(m2, __shfl_xor(m2, 1)); m2 = fmaxf(m2, __shfl_xor(m2, 2)); m2 = fmaxf(m2, __shfl_xor(m2, 4));
            const float grp = m1 + m2; const int gi = lane >> 3;
            int grank = 0;
#pragma unroll
            for (int gj = 0; gj < 8; ++gj) { const float og = __shfl(grp, gj * 8); grank += (og > grp || (og == grp && gj < gi)) ? 1 : 0; }
            const float mv = (grank < 4) ? bv : -__builtin_inff();
            int rank = 0;
#pragma unroll 8
            for (int e2 = 0; e2 < 64; ++e2) { const float ov = __shfl(mv, e2); rank += (ov > mv || (ov == mv && e2 < lane)) ? 1 : 0; }
            const bool chosen = rank < 8;
            float gs = chosen ? sg : 0.f; gs = wave_sum(gs);
            rk[q] = chosen ? rank : -1; gk[q] = sg * (2.5f / gs);
            sl[q] = chosen ? __hip_atomic_fetch_add(&lcnt[lane], 1, __ATOMIC_RELAXED, __HIP_MEMORY_SCOPE_WORKGROUP) : 0;
        }
        __syncthreads();
        if (tid < 64) { const int n = lcnt[tid]; lbase[tid] = n ? (int)atomicAdd(&gcnt[tid], (unsigned)n) : 0; }
        __syncthreads();
        { const int base = lbase[lane];
#pragma unroll
          for (int q = 0; q < 4; ++q) if (rk[q] >= 0) { const int tok = tok0 + wid * 4 + q, slot = base + sl[q];
              slot_tok[(size_t)lane * T + slot] = tok; rte[tok * 8 + rk[q]] = lane; rts[tok * 8 + rk[q]] = slot; rtg[tok * 8 + rk[q]] = gk[q]; } }
    }
    __syncthreads();
}

__device__ __forceinline__ void moe_tables(const Ctx& C, int l) {
    const unsigned* gcnt = (const unsigned*)(C.ws + WS_CTL) + CW_CNT + l * 64;
    LAS int* cnt = (LAS int*)(C.ldsl + LDS_TAB); LAS int* ptile = cnt + 64;
    __syncthreads();
    if (C.tid == 0) { int acc = 0; for (int e = 0; e < NE; ++e) { const int n = (int)gcnt[e]; cnt[e] = n; ptile[e] = acc; acc += (n + 255) >> 8; } ptile[NE] = acc; }
    __syncthreads();
    LAS int* pexp = ptile + 80;
    for (int p = C.tid; p < PMAX / 256; p += NTHR) { int e = 0; for (int j = 1; j < NE; ++j) e += (ptile[j] <= p) ? 1 : 0; pexp[p] = e; }
    __syncthreads();
}

template <int MODE>
__device__ __forceinline__ void phase_combine(const Ctx& C, int l, const bf16_t* x1, bf16_t* x2) {
    const unsigned* gcnt = (const unsigned*)(C.ws + WS_CTL) + CW_CNT + l * 64;
    const float* mod = (const float*)(C.ws + WS_MOD) + (size_t)l * NB * 6 * DM; const float* mgf = mod + 5 * DM;
    const unsigned char* y = C.ws + WS_Y; const unsigned char* ys = C.ws + WS_YS;
    const int* rte = (const int*)(C.ws + WS_RTE); const int* rts = (const int*)(C.ws + WS_RTS); const float* rtg = (const float*)(C.ws + WS_RTG);
    const int lane = C.lane;
    int pt; { const int n = (int)gcnt[lane]; const int tl = (n + 255) >> 8; int inc = tl;
#pragma unroll
        for (int o = 1; o < 64; o <<= 1) { const int v = __shfl_up(inc, o); if (lane >= o) inc += v; }
        pt = inc - tl; }
    const float* gN = (MODE == 0) ? C.ap->in[I_NMG] + (size_t)(l + 1) * DM : C.ap->in[I_FG];
    const float* modN = (const float*)(C.ws + WS_MOD) + (size_t)(l + 1) * NB * 6 * DM;
    unsigned char* h8 = C.ws + WS_H8; bf16_t* h = (bf16_t*)(C.ws + WS_H);
    for (int chunk = C.gw; chunk < T / 8; chunk += C.NGW) {
        const int row0 = chunk * 8, b = row0 / SEQ;
        f32x4 gfv[4][2], anv[4][2];
#pragma unroll
        for (int j = 0; j < 4; ++j)
#pragma unroll
            for (int q = 0; q < 2; ++q) { const int col = 8 * lane + 512 * j + 4 * q; const f32x4 gg = *(const f32x4*)(gN + col);
                gfv[j][q] = *(const f32x4*)(mgf + (size_t)b * 6 * DM + col);
                if (MODE == 0) anv[j][q] = gg * (*(const f32x4*)(modN + (size_t)b * 6 * DM + DM + col) + 1.f); else anv[j][q] = gg; }
        int yrow_l; float gate_l;
        { const int e = rte[row0 * 8 + lane], slot = rts[row0 * 8 + lane]; gate_l = rtg[row0 * 8 + lane] * (1.f / Y_SCALE); yrow_l = __shfl(pt, e) * 256 + slot; }
#pragma unroll 1
        for (int r = 0; r < 8; ++r) {
            const int t = row0 + r;
            const unsigned char* yr[8]; float gk[8];
#pragma unroll
            for (int k = 0; k < 8; ++k) { const int yrow = __builtin_amdgcn_readlane(yrow_l, r * 8 + k); gk[k] = __int_as_float(__builtin_amdgcn_readlane(__float_as_int(gate_l), r * 8 + k));
                yr[k] = y + (size_t)(unsigned)yrow * DM + 8 * lane; }
            f32x4 acc[4][2]; float ss = 0.f;
#pragma unroll
            for (int h2 = 0; h2 < 2; ++h2) {
                u32x2 yv[8][2], ysv[2]; u32x4 xw[2]; f32x4 xv[2][2];
#pragma unroll
                for (int k = 0; k < 8; ++k)
#pragma unroll
                    for (int jj = 0; jj < 2; ++jj) yv[k][jj] = *(const u32x2*)(yr[k] + 512 * (2 * h2 + jj));
#pragma unroll
                for (int jj = 0; jj < 2; ++jj) { const int col = 8 * lane + 512 * (2 * h2 + jj);
                    ysv[jj] = *(const u32x2*)(ys + (size_t)t * DM + col);
                    xw[jj] = *(const u32x4*)(x1 + (size_t)t * DM + col); }
#pragma unroll
                for (int jj = 0; jj < 2; ++jj) {
                    f32x4 a0, a1; { const f32x2 q0 = __builtin_amdgcn_cvt_pk_f32_fp8((int)ysv[jj].x, false), q1 = __builtin_amdgcn_cvt_pk_f32_fp8((int)ysv[jj].x, true), q2 = __builtin_amdgcn_cvt_pk_f32_fp8((int)ysv[jj].y, false), q3 = __builtin_amdgcn_cvt_pk_f32_fp8((int)ysv[jj].y, true);
                        a0 = (f32x4){q0[0], q0[1], q1[0], q1[1]} * (1.f / Y_SCALE); a1 = (f32x4){q2[0], q2[1], q3[0], q3[1]} * (1.f / Y_SCALE); }
#pragma unroll
                    for (int k = 0; k < 8; ++k) { const u32x2 w = yv[k][jj]; const float gt = gk[k];
                        const f32x2 p0 = __builtin_amdgcn_cvt_pk_f32_fp8((int)w.x, false), p1 = __builtin_amdgcn_cvt_pk_f32_fp8((int)w.x, true), p2 = __builtin_amdgcn_cvt_pk_f32_fp8((int)w.y, false), p3 = __builtin_amdgcn_cvt_pk_f32_fp8((int)w.y, true);
                        a0[0] = fmaf(gt, p0[0], a0[0]); a0[1] = fmaf(gt, p0[1], a0[1]); a0[2] = fmaf(gt, p1[0], a0[2]); a0[3] = fmaf(gt, p1[1], a0[3]);
                        a1[0] = fmaf(gt, p2[0], a1[0]); a1[1] = fmaf(gt, p2[1], a1[1]); a1[2] = fmaf(gt, p3[0], a1[2]); a1[3] = fmaf(gt, p3[1], a1[3]); }
                    xv[jj][0] = (f32x4){bflo(xw[jj].x), bfhi(xw[jj].x), bflo(xw[jj].y), bfhi(xw[jj].y)}; xv[jj][1] = (f32x4){bflo(xw[jj].z), bfhi(xw[jj].z), bflo(xw[jj].w), bfhi(xw[jj].w)};
                    a0 = xv[jj][0] + gfv[2 * h2 + jj][0] * a0; a1 = xv[jj][1] + gfv[2 * h2 + jj][1] * a1;
                    ss += ((a0[0] * a0[0] + a0[1] * a0[1]) + (a0[2] * a0[2] + a0[3] * a0[3])) + ((a1[0] * a1[0] + a1[1] * a1[1]) + (a1[2] * a1[2] + a1[3] * a1[3]));
                    acc[2 * h2 + jj][0] = a0; acc[2 * h2 + jj][1] = a1; }
            }
            const float rstd = rsqrtf(wave_sum(ss) * (1.f / DM) + EPS);
#pragma unroll
            for (int j = 0; j < 4; ++j) { const int col = 8 * lane + 512 * j;
                if (MODE == 0) { { u32x4 xo; xo.x = cvtpk(acc[j][0][0], acc[j][0][1]); xo.y = cvtpk(acc[j][0][2], acc[j][0][3]); xo.z = cvtpk(acc[j][1][0], acc[j][1][1]); xo.w = cvtpk(acc[j][1][2], acc[j][1][3]); *(u32x4*)(x2 + (size_t)t * DM + col) = xo; }
                    const f32x4 y0 = acc[j][0] * rstd * anv[j][0] + *(const f32x4*)(modN + (size_t)b * 6 * DM + col), y1 = acc[j][1] * rstd * anv[j][1] + *(const f32x4*)(modN + (size_t)b * 6 * DM + col + 4);
                    if (WIN_FP8 != 0) { u32x2 w8; w8.x = pk4_fp8(y0[0], y0[1], y0[2], y0[3]); w8.y = pk4_fp8(y1[0], y1[1], y1[2], y1[3]); *(u32x2*)(h8 + (size_t)t * DM + col) = w8; }
                    if (WIN_FP8 != 1) { u32x4 w; w.x = cvtpk(y0[0], y0[1]); w.y = cvtpk(y0[2], y0[3]); w.z = cvtpk(y1[0], y1[1]); w.w = cvtpk(y1[2], y1[3]); *(u32x4*)(h + (size_t)t * DM + col) = w; } }
                else { *(f32x4*)(C.out + (size_t)t * DM + col) = acc[j][0] * rstd * anv[j][0]; *(f32x4*)(C.out + (size_t)t * DM + col + 4) = acc[j][1] * rstd * anv[j][1]; } }
        }
    }
}

#define OPTR(base, idx) (WO_FP8 ? (bf16_t*)((unsigned char*)(base) + (size_t)(idx)) : ((base) + (size_t)(idx)))
__device__ __forceinline__ void phase_attn_mla(const Ctx& C, int l, int vcu) {
    const bf16_t* qbuf = (const bf16_t*)(C.ws + WS_Q); const bf16_t* kvbuf = (const bf16_t*)(C.ws + WS_KV); const bf16_t* proj = (const bf16_t*)(C.ws + WS_PROJ);
    const float* cs = (const float*)(C.ws + WS_CS); bf16_t* obuf = (bf16_t*)(C.ws + WS_O); const float* gout = C.ap->in[I_GOUT] + (size_t)l * DM;
    for (int it = vcu; it < NB * 8 * 4; it += C.G) {
        const int b = it >> 5, h = (it >> 2) & 7, i = it & 3;
#pragma unroll 1
        for (int pass = 0; pass < 2; ++pass) {
            const int qb = pass ? i : 7 - i, q0 = qb * 256, qlo = q0 + 32 * C.wave; const size_t trow = (size_t)b * SEQ + qlo;
            AttnWave A;
            A.Q = qbuf + trow * 1536 + h * 192; A.ldq = 1536; A.cs = cs + trow * 64;
            A.K = kvbuf + (size_t)b * SEQ * 2048 + h * 256; A.ldk = 2048; A.KR = proj + (size_t)b * SEQ * NPROJ + O_KR; A.ldkr = NPROJ;
            A.V = kvbuf + (size_t)b * SEQ * 2048 + h * 256 + 128; A.ldv = 2048; A.mw = nullptr;
            A.O = OPTR(obuf, trow * DM + h * 128); A.ldo = DM; A.gout = gout + h * 128; A.qlo = qlo; A.nt_w = (qlo + 31) / 64 + 1;
            attn_softmax_block<0>(C.ldsl, C.tid, A, (q0 + 255) / 64 + 1, 0.07216878364870322f);
        }
    }
}
__device__ __forceinline__ void phase_attn_sb(const Ctx& C, int l, int vcu) {
    const bf16_t* proj = (const bf16_t*)(C.ws + WS_PROJ); bf16_t* obuf = (bf16_t*)(C.ws + WS_O); const float* gout = C.ap->in[I_GOUT] + (size_t)l * DM;
    for (int it = vcu; it < NB * 4 * 8; it += C.G) {
        const int b = it >> 5, h = (it >> 3) & 3, qb = 7 - (it & 7), q0 = qb * 256, qlo = q0 + 32 * C.wave; const size_t trow = (size_t)b * SEQ + qlo;
        AttnWave A;
        A.Q = proj + trow * NPROJ + O_SBQ + h * 128; A.ldq = NPROJ; A.cs = nullptr;
        A.K = proj + (size_t)b * SEQ * NPROJ + O_SBK + h * 128; A.ldk = NPROJ; A.KR = nullptr; A.ldkr = 0;
        A.V = proj + (size_t)b * SEQ * NPROJ + O_SBV + h * 128; A.ldv = NPROJ; A.mw = nullptr;
        A.O = OPTR(obuf, trow * DM + (8 + h) * 128); A.ldo = DM; A.gout = gout + (8 + h) * 128; A.qlo = qlo; A.nt_w = (qlo + 30) / 64 + 1;
        attn_sb_block(C.ldsl, C.tid, A, (q0 + 254) / 64 + 1, 0.08838834764831845f);
    }
}
__device__ __forceinline__ void phase_attn_dsa(const Ctx& C, int l, int vcu) {
    const bf16_t* proj = (const bf16_t*)(C.ws + WS_PROJ); bf16_t* obuf = (bf16_t*)(C.ws + WS_O); const float* gout = C.ap->in[I_GOUT] + (size_t)l * DM;
    const unsigned long long* mask = (const unsigned long long*)(C.ws + WS_MASK);
    for (int it = vcu; it < NB * 32; it += C.G) {
        const int b = it >> 5, i = it & 31, head = C.wave & 3;
#pragma unroll 1
        for (int pass = 0; pass < 2; ++pass) {
            const int qblk = pass ? i : 63 - i, q0 = qblk * 32; const size_t trow = (size_t)b * SEQ + q0;
            AttnWave A;
            A.Q = proj + trow * NPROJ + O_DSQ + head * 128; A.ldq = NPROJ; A.cs = nullptr;
            A.K = proj + (size_t)b * SEQ * NPROJ + O_DSK; A.ldk = NPROJ; A.KR = nullptr; A.ldkr = 0;
            A.V = proj + (size_t)b * SEQ * NPROJ + O_DSV; A.ldv = NPROJ; A.mw = mask + trow * 32;
            A.O = OPTR(obuf, trow * DM + (12 + head) * 128); A.ldo = DM; A.gout = gout + (12 + head) * 128; A.qlo = q0; A.nt_w = (q0 + 31) / 64 + 1;
            attn_dsa_block(C.ldsl, C.tid, A, (q0 + 31) / 64 + 1, 0.08838834764831845f);
        }
    }
}

constexpr int NPHASE = 2 + 10 * NL;
#ifndef PHMASK
#define PHMASK 0xFFFFFFFFu
#endif
#define EN(j) ((PHMASK >> (j)) & 1u)
#ifndef REPMASK
#define REPMASK 0u
#endif
#define NREP(j) (1 + (int)((REPMASK >> (j)) & 1u))
#define WSP(T_, off) ((T_*)(C.ws + (off)))
__global__ void __launch_bounds__(NTHR, 2) fwd(Args args) {
    extern __shared__ __attribute__((aligned(16))) unsigned char lds[];
    const int lo = args.ph_lo, hi = args.ph_hi;
    const int wave_s = __builtin_amdgcn_readfirstlane((int)threadIdx.x >> 6);
    if (threadIdx.x < 64) ((LAS unsigned*)((LAS unsigned char*)lds + LDS_MISC))[threadIdx.x] = 0u;
    __syncthreads();
    XcdBarrier bar; bar.bar = (unsigned*)(args.ws + WS_CTL); bar.x = 0; bar.st = (volatile LAS unsigned*)((LAS unsigned char*)lds + LDS_MISC);
    if (hi - lo > 1) bar = xcd_barrier_post((unsigned*)(args.ws + WS_CTL), (volatile LAS unsigned*)((LAS unsigned char*)lds + LDS_MISC), wave_s);
#define IN(k) (lo <= (k) && (k) < hi)
#ifndef SEAMREP
#define SEAMREP 1
#endif
#define SEAM(k) do { if (lo <= (k) && (k) + 1 < hi) { for (int sr_ = 0; sr_ < SEAMREP; ++sr_) xcd_barrier(bar, wave_s); } } while (0)
#define SECTION() asm volatile("; SECMARK %0" :: "i"(__LINE__)); Ctx C; ctx_init(C, lds, wave_s)
#ifndef NO_FILL
#define FILL() do { if (hi - lo > 1) { ++nfill; SECTION(); cvt_fill(C, (unsigned)(nfill * (int)gridDim.x)); } } while (0)
#else
#define FILL() do { } while (0)
#endif
    int nfill = 0;

    if (EN(0) && IN(0)) { for (int ra = 0; ra < NREP(1); ++ra) { SECTION(); phase_adaln(C); __syncthreads(); } __syncthreads(); for (int rp = 0; rp < NREP(0); ++rp) { SECTION(); phase_convert(C); } SEAM(0); }
    if (EN(1) && IN(1)) { SECTION(); const float* modp = WSP(float, WS_MOD);
        for (int chunk = C.gw; chunk < T / 8; chunk += C.NGW) norm_mod_rows(C.ap->in[I_X], C.ap->in[I_NMG], modp, modp + DM, C.ws + WS_H8, WSP(bf16_t, WS_H), chunk * 8, 8, C.lane);
        SEAM(1); }
#pragma unroll 1
    for (int l = 0; l < NL; ++l) {
        const int pb = 2 + 10 * l;
        if (EN(2) && IN(pb + 0)) {
            SECTION(); unsigned char* wl = C.ws + WS_W + (size_t)l * LW_BYTES;
#if WIN_FP8 == 1
            pg8::DenseOrder S; S.init(T, NPROJ, DM / 2, DM / 2, wl + LW_IN, C.G, C.bid);
            pg8::EpiBf16S E{WSP(bf16_t, WS_PROJ), NPROJ, 1.f / W1_SCALE};
            pg8::gemm_phase<pg8::EpiBf16S, pg8::DenseOrder, true>(C.ldsl, C.tid, (const char*)(C.ws + WS_H8), DM / 2, S, E);
            if (NREP(2) > 1) { SECTION(); unsigned char* wl3 = C.ws + WS_W + (size_t)l * LW_BYTES; pg8::DenseOrder S3; S3.init(T, NPROJ, DM / 2, DM / 2, wl3 + LW_IN, C.G, C.bid);
                pg8::EpiBf16S E3{WSP(bf16_t, WS_PROJ), NPROJ, 1.f / W1_SCALE}; pg8::gemm_phase<pg8::EpiBf16S, pg8::DenseOrder, true>(C.ldsl, C.tid, (const char*)(C.ws + WS_H8), DM / 2, S3, E3); }
#elif WIN_FP8 == 2
            { pg8::DenseOrder S; S.init(T, NPROJ - WIN_NB * 256, DM / 2, DM / 2, wl + LW_IN, C.G, C.bid); S.pn_cut = WIN_B0; S.pn_add = WIN_NB;
              pg8::EpiBf16S E{WSP(bf16_t, WS_PROJ), NPROJ, 1.f / W1_SCALE};
              pg8::gemm_phase<pg8::EpiBf16S, pg8::DenseOrder, true>(C.ldsl, C.tid, (const char*)(C.ws + WS_H8), DM / 2, S, E); }
            { SECTION(); unsigned char* wl2 = C.ws + WS_W + (size_t)l * LW_BYTES;
              pg8::DenseOrder S; S.init(T, WIN_NB * 256, DM, DM, wl2 + LW_IN + (size_t)NPROJ * DM, C.G, C.bid); S.pn_off = WIN_B0; S.pn_boff = WIN_B0;
              pg8::EpiBf16S E{WSP(bf16_t, WS_PROJ), NPROJ, 1.f};
              pg8::gemm_phase(C.ldsl, C.tid, (const char*)WSP(bf16_t, WS_H), DM, S, E); }
#else
            pg8::DenseOrder S; S.init(T, NPROJ, DM, DM, wl + LW_IN, C.G, C.bid);
            pg8::EpiBf16S E{WSP(bf16_t, WS_PROJ), NPROJ, 1.f};
            pg8::gemm_phase(C.ldsl, C.tid, (const char*)WSP(bf16_t, WS_H), DM, S, E);
#endif
#ifndef NOFILL_A
            FILL();
#endif
            SEAM(pb + 0);
        }
        if (EN(3) && IN(pb + 1)) { SECTION(); phase_postproj(C, l); SEAM(pb + 1); }
        if (EN(4) && IN(pb + 2)) { for (int rp = 0; rp < NREP(4); ++rp) {
            { SECTION(); unsigned char* wl = C.ws + WS_W + (size_t)l * LW_BYTES;
#if UQ_FP8
              pg8::DenseOrder S; S.init(T, 1536, 256, 256, wl + LW_UQ, C.G, C.bid); pg8::EpiBf16S E{WSP(bf16_t, WS_Q), 1536, 1.f / W1_SCALE};
              pg8::gemm_phase<pg8::EpiBf16S, pg8::DenseOrder, true>(C.ldsl, C.tid, (const char*)(C.ws + WS_CQ8), 256, S, E); }
#else
              pg8::DenseOrder S; S.init(T, 1536, 512, NPROJ, wl + LW_UQ, C.G, C.bid); pg8::EpiBf16S E{WSP(bf16_t, WS_Q), 1536, 1.f};
              pg8::gemm_phase(C.ldsl, C.tid, (const char*)(WSP(bf16_t, WS_PROJ) + O_CQ), 512, S, E); }
#endif
#ifndef NO_GEMMKV
            { SECTION(); unsigned char* wl = C.ws + WS_W + (size_t)l * LW_BYTES;
              pg8::DenseOrder S; S.init(T, 2048, 256, NPROJ, wl + LW_UKV, C.G, C.bid); pg8::EpiBf16S E{WSP(bf16_t, WS_KV), 2048, 1.f};
              pg8::gemm_phase(C.ldsl, C.tid, (const char*)(WSP(bf16_t, WS_PROJ) + O_CKV), 256, S, E); }
#endif
#ifndef NO_INDEXER
            for (int r2 = 0; r2 < NREP(15); ++r2) { SECTION(); phase_indexer(C); }
#endif
            }
            FILL();
            SEAM(pb + 2);
        }
        if (EN(5) && IN(pb + 3)) { for (int rp = 0; rp < NREP(5); ++rp) {
#if QUOTA_R > 0
            { SECTION(); if (C.bid % 3 == 0) cvt_quota(C, QUOTA_R); }
#endif
#ifndef NO_SELECT
            for (int r2 = 0; r2 < NREP(12); ++r2) { SECTION(); phase_select(C); }
#endif
#ifndef NO_MLA
            for (int r2 = 0; r2 < NREP(13); ++r2) { SECTION(); phase_attn_mla(C, l, C.vcu); }
#endif
#if QUOTA_R > 0
            { SECTION(); if (C.bid % 3 == 1) cvt_quota(C, QUOTA_R); }
#endif
#ifndef NO_SB
            for (int r2 = 0; r2 < NREP(14); ++r2) { SECTION(); phase_attn_sb(C, l, C.vcu); }
#endif
            }
            FILL();
            SEAM(pb + 3); }
        if (EN(6) && IN(pb + 4)) { for (int rp = 0; rp < NREP(6); ++rp) { SECTION(); phase_attn_dsa(C, l, C.vcu); } FILL(); SEAM(pb + 4); }
        if (EN(7) && IN(pb + 5)) {
            SECTION(); unsigned char* wl = C.ws + WS_W + (size_t)l * LW_BYTES;
            const float* gate = WSP(const float, WS_MOD) + (size_t)l * NB * 6 * DM + 2 * DM;
#if WO_FP8
            pg8::DenseOrder S; S.init(T, DM, DM / 2, DM / 2, wl + LW_O, C.G, C.bid);
            if (l == 0) { pg8::EpiResidT<false> E{C.ap->in[I_X], WSP(bf16_t, WS_X1), gate, 1.f / W1_SCALE}; pg8::gemm_phase<pg8::EpiResidT<false>, pg8::DenseOrder, true>(C.ldsl, C.tid, (const char*)WSP(bf16_t, WS_O), DM / 2, S, E); }
            else { pg8::EpiResidT<true> E{WSP(const bf16_t, WS_X2), WSP(bf16_t, WS_X1), gate, 1.f / W1_SCALE}; pg8::gemm_phase<pg8::EpiResidT<true>, pg8::DenseOrder, true>(C.ldsl, C.tid, (const char*)WSP(bf16_t, WS_O), DM / 2, S, E); }
            if (NREP(7) > 1) { SECTION(); unsigned char* wl3 = C.ws + WS_W + (size_t)l * LW_BYTES; const float* gate3 = WSP(const float, WS_MOD) + (size_t)l * NB * 6 * DM + 2 * DM;
                pg8::DenseOrder S3; S3.init(T, DM, DM / 2, DM / 2, wl3 + LW_O, C.G, C.bid);
                pg8::EpiResidT<true> E3{WSP(const bf16_t, WS_X2), WSP(bf16_t, WS_X1), gate3, 1.f / W1_SCALE}; if (l == 1) pg8::gemm_phase<pg8::EpiResidT<true>, pg8::DenseOrder, true>(C.ldsl, C.tid, (const char*)WSP(bf16_t, WS_O), DM / 2, S3, E3); }
#else
            pg8::DenseOrder S; S.init(T, DM, DM, DM, wl + LW_O, C.G, C.bid);
            if (l == 0) { pg8::EpiResidT<false> E{C.ap->in[I_X], WSP(bf16_t, WS_X1), gate, 1.f}; pg8::gemm_phase(C.ldsl, C.tid, (const char*)WSP(bf16_t, WS_O), DM, S, E); }
            else { pg8::EpiResidT<true> E{WSP(const bf16_t, WS_X2), WSP(bf16_t, WS_X1), gate, 1.f}; pg8::gemm_phase(C.ldsl, C.tid, (const char*)WSP(bf16_t, WS_O), DM, S, E); }
#endif
            SEAM(pb + 5);
        }
        if (EN(8) && IN(pb + 6)) { if (NREP(8) > 1) { SECTION(); phase_router(C, l, WSP(const bf16_t, WS_X1), false); } { SECTION(); phase_router(C, l, WSP(const bf16_t, WS_X1)); } { SECTION(); cvt_drain(C, l); } SEAM(pb + 6); }
        if (EN(9) && IN(pb + 7)) { for (int rp = 0; rp < NREP(9); ++rp) {
            { SECTION(); moe_tables(C, l); unsigned char* wl = C.ws + WS_W + (size_t)l * LW_BYTES;
              pg8::GroupOrder<true> S; S.init((const LAS int*)(C.ldsl + LDS_TAB), (const LAS int*)(C.ldsl + LDS_TAB) + 64, 4, DM / 2, DM / 2, wl + LW_1, (size_t)1024 * DM, WSP(const int, WS_ST), C.G, C.bid);
              pg8::EpiSwiglu8 E{WSP(bf16_t, WS_H1), 512, 1.f / W1_SCALE};
              pg8::gemm_phase<pg8::EpiSwiglu8, pg8::GroupOrder<true>, true>(C.ldsl, C.tid, (const char*)(C.ws + WS_H8), DM / 2, S, E); }
            { SECTION(); unsigned char* wl = C.ws + WS_W + (size_t)l * LW_BYTES;
#if SH_FP8
              pg8::DenseOrder S; S.init(T, 1024, DM / 2, DM / 2, wl + LW_S1, C.G, C.bid); pg8::EpiSwiglu8 E{WSP(bf16_t, WS_HS), 512, 1.f / W1_SCALE};
              pg8::gemm_phase<pg8::EpiSwiglu8, pg8::DenseOrder, true>(C.ldsl, C.tid, (const char*)(C.ws + WS_H8), DM / 2, S, E); }
#else
              pg8::DenseOrder S; S.init(T, 1024, DM, DM, wl + LW_S1, C.G, C.bid); pg8::EpiSwiglu E{WSP(bf16_t, WS_HS), 512, 1.f};
              pg8::gemm_phase(C.ldsl, C.tid, (const char*)WSP(bf16_t, WS_H), DM, S, E); }
#endif
            }
#ifndef NOFILL_B
            if (l == 0) FILL();
#endif
            SEAM(pb + 7);
        }
        if (EN(10) && IN(pb + 8)) { for (int rp = 0; rp < NREP(10); ++rp) {
            { SECTION(); moe_tables(C, l); unsigned char* wl = C.ws + WS_W + (size_t)l * LW_BYTES;
              pg8::GroupOrder<false> S; S.init((const LAS int*)(C.ldsl + LDS_TAB), (const LAS int*)(C.ldsl + LDS_TAB) + 64, 8, 256, 256, wl + LW_2, (size_t)DM * 512, nullptr, C.G, C.bid);
              pg8::EpiFp8S E{C.ws + WS_Y, DM, Y_SCALE / W2_SCALE};
              pg8::gemm_phase<pg8::EpiFp8S, pg8::GroupOrder<false>, true>(C.ldsl, C.tid, (const char*)WSP(bf16_t, WS_H1), 256, S, E); }
            { SECTION(); unsigned char* wl = C.ws + WS_W + (size_t)l * LW_BYTES;
#if SH_FP8
              pg8::DenseOrder S; S.init(T, DM, 256, 256, wl + LW_S2, C.G, C.bid); pg8::EpiFp8S E{C.ws + WS_YS, DM, Y_SCALE / W2_SCALE};
              pg8::gemm_phase<pg8::EpiFp8S, pg8::DenseOrder, true>(C.ldsl, C.tid, (const char*)WSP(bf16_t, WS_HS), 256, S, E); }
#else
              pg8::DenseOrder S; S.init(T, DM, 512, 512, wl + LW_S2, C.G, C.bid); pg8::EpiBf16S E{WSP(bf16_t, WS_YS), DM, 1.f};
              pg8::gemm_phase(C.ldsl, C.tid, (const char*)WSP(bf16_t, WS_HS), 512, S, E); }
#endif
            }
#ifndef NOFILL_B
            if (l == 0) FILL();
#endif
            SEAM(pb + 8);
        }
        if (EN(11) && IN(pb + 9)) {
            for (int rp = 0; rp < NREP(11); ++rp) { SECTION();
            if (l == 0) phase_combine<0>(C, l, WSP(const bf16_t, WS_X1), WSP(bf16_t, WS_X2)); else phase_combine<1>(C, l, WSP(const bf16_t, WS_X1), WSP(bf16_t, WS_X2)); }
            SEAM(pb + 9);
        }
    }
#undef IN
#undef SEAM
}

#ifndef MK_FUSED
#define MK_FUSED 0
#endif
extern "C" void kernel_launch(void* const* d_in, const int* in_sizes, int n_in, void* d_out, int out_size, void* d_ws, size_t ws_size, hipStream_t stream) {
    static int grid = 0;
    if (grid == 0) {
        if (n_in != 23 || out_size != T * DM || ws_size < WS_END) { fprintf(stderr, "kernel_launch: unexpected shapes (n_in %d, out %d, ws %zu < %zu)\n", n_in, out_size, ws_size, (size_t)WS_END); grid = -1; return; }
        int dev = 0, cus = 0;
        if (hipGetDevice(&dev) != hipSuccess || hipDeviceGetAttribute(&cus, hipDeviceAttributeMultiprocessorCount, dev) != hipSuccess) { grid = -1; return; }
#ifndef NO_ATTR
        if (hipFuncSetAttribute((const void*)fwd, hipFuncAttributeMaxDynamicSharedMemorySize, LDS_BYTES) != hipSuccess) { fprintf(stderr, "kernel_launch: hipFuncSetAttribute failed\n"); grid = -1; return; }
#endif
#ifndef NO_OCC
        int per_cu = 0;
        if (hipOccupancyMaxActiveBlocksPerMultiprocessor(&per_cu, (const void*)fwd, NTHR, LDS_BYTES) != hipSuccess || per_cu < 1) fprintf(stderr, "kernel_launch: occupancy query says %d\n", per_cu);
        (void)hipGetLastError();
#endif
        grid = cus;
    }
    if (grid < 0) return;
    (void)hipMemsetAsync((char*)d_ws + WS_CTL, 0, CTL_BYTES, stream);
    Args a{};
    for (int i = 0; i < 23; ++i) a.in[i] = (const float*)d_in[i];
    a.out = (float*)d_out; a.ws = (unsigned char*)d_ws;
#if MK_FUSED
    a.ph_lo = 0; a.ph_hi = NPHASE;
    hipLaunchKernelGGL(fwd, dim3(grid), dim3(NTHR), LDS_BYTES, stream, a);
#else
#ifndef MAXPH
#define MAXPH NPHASE
#endif
    for (int p = 0; p < MAXPH; ++p) { a.ph_lo = p; a.ph_hi = p + 1; hipLaunchKernelGGL(fwd, dim3(grid), dim3(NTHR), LDS_BYTES, stream, a); }
#endif
}
```

```cpp
#ifndef MK_FUSED
#define MK_FUSED 1
#endif
#ifndef WIN_FP8
#define WIN_FP8 1
#endif
#ifndef SH_FP8
#define SH_FP8 1
#endif
#ifndef QUOTA_R
#define QUOTA_R 0
#endif
#ifndef STAGGER_SLEEP
#define STAGGER_SLEEP 0
#endif
#ifndef DEFER_STORE
#define DEFER_STORE 0
#endif
#ifndef UQ_FP8
#define UQ_FP8 1
#endif
#ifndef UKV_FP8
#define UKV_FP8 1
#endif
#ifndef RESID_PREFETCH
#define RESID_PREFETCH 0
#endif
#ifndef ALIGN_EPI
#define ALIGN_EPI 1
#endif
#ifndef JIT_WAITS
#define JIT_WAITS 0
#endif
#ifndef Y_TILED
#define Y_TILED 0
#endif
#ifndef WO_FP8
#define WO_FP8 1
#endif
#include <hip/hip_runtime.h>
#include <cstdio>
#include <cstdint>

#define LAS __attribute__((address_space(3)))
typedef unsigned short bf16_t;
typedef short bf16x8 __attribute__((ext_vector_type(8)));
typedef short s16x4 __attribute__((ext_vector_type(4)));
typedef float f32x2 __attribute__((ext_vector_type(2)));
typedef float f32x4 __attribute__((ext_vector_type(4)));
typedef float f32x16 __attribute__((ext_vector_type(16)));
typedef unsigned u32x2 __attribute__((ext_vector_type(2)));
typedef unsigned u32x4 __attribute__((ext_vector_type(4)));

constexpr int NB = 8, SEQ = 2048, T = NB * SEQ, DM = 2048, NL = 2;
constexpr int NPROJ = 4352, INW = 4240;
constexpr int O_CQ = 0, O_CKV = 512, O_KR = 768, O_SBQ = 832, O_SBK = 1344, O_SBV = 1856, O_DSQ = 2368, O_DSK = 2880, O_DSV = 3008,
              O_IXQ = 3136, O_IXK = 4160, O_IXW = 4224;
constexpr int NE = 64, TOPK = 8, DE = 512;
constexpr int PMAX = T * TOPK + NE * 256;
constexpr float EPS = 1e-6f;
constexpr int NWAVES = 8, NTHR = 512;
#ifdef SMALL_LDS
constexpr int LDS_BYTES = 32768; constexpr int LDS_MISC = 16384;
#else
constexpr int LDS_BYTES = 147456;
constexpr int LDS_MISC = 140 * 1024;
#endif
constexpr int LDS_TAB = 132 * 1024;

constexpr size_t WS_CTL = 0, CTL_BYTES = 1u << 20;
constexpr size_t WS_MOD = WS_CTL + CTL_BYTES;
constexpr size_t WS_W = WS_MOD + (1u << 20);
constexpr size_t LW_IN = 0;
constexpr size_t LW_UQ = LW_IN + (size_t)NPROJ * DM * 2;
constexpr size_t LW_UKV = LW_UQ + (size_t)1536 * 512 * 2;
constexpr size_t LW_O = LW_UKV + (size_t)2048 * 256 * 2;
constexpr size_t LW_S1 = LW_O + (size_t)DM * DM * 2;
constexpr size_t LW_S2 = LW_S1 + (size_t)1024 * DM * 2;
constexpr size_t LW_R = LW_S2 + (size_t)DM * 512 * 2;
constexpr size_t LW_1 = LW_R + (size_t)64 * DM * 2;
constexpr size_t LW_2 = LW_1 + (size_t)NE * 1024 * DM;
constexpr size_t LW_BYTES = LW_2 + (size_t)NE * DM * 512 * 2;
constexpr size_t WS_ACT = WS_W + NL * LW_BYTES;
constexpr size_t WS_H = WS_ACT;
constexpr size_t WS_CQ8 = WS_ACT;
constexpr size_t WS_CKV8 = WS_CQ8 + (size_t)T * 512;
static_assert(!(UQ_FP8 && (WIN_FP8 != 1 || !SH_FP8)), "WS_CQ8 overlays the bf16 activation buffer");
constexpr size_t WS_H8 = WS_H + (size_t)T * DM * 2;
constexpr size_t WS_X1 = WS_H8 + (size_t)T * DM;
constexpr size_t WS_X2 = WS_X1 + (size_t)T * DM * 4;
constexpr size_t WS_RTE = WS_X2 + (size_t)T * DM * 4;
constexpr size_t WS_RTS = WS_RTE + (size_t)T * 8 * 4;
constexpr size_t WS_RTG = WS_RTS + (size_t)T * 8 * 4;
constexpr size_t WS_ST = WS_RTG + (size_t)T * 8 * 4;
constexpr size_t WS_UN = WS_ST + (size_t)NE * T * 4;
constexpr size_t WS_PROJ = WS_UN;
constexpr size_t WS_Q = WS_PROJ + (size_t)T * NPROJ * 2;
constexpr size_t WS_KV = WS_Q + (size_t)T * 1536 * 2;
constexpr size_t WS_CS = WS_KV + (size_t)T * 2048 * 2;
constexpr size_t WS_SC = WS_CS + (size_t)T * 64 * 4;
constexpr size_t WS_MASK = WS_SC + (size_t)T * SEQ * 4;
constexpr size_t WS_O = WS_MASK + (size_t)T * 32 * 8;
constexpr size_t WS_MIX_END = WS_O + (size_t)T * DM * 2;
constexpr size_t WS_H1 = WS_UN;
constexpr size_t WS_HS = WS_H1 + (size_t)PMAX * 512 * 2;
constexpr size_t WS_Y = WS_HS + (size_t)T * 512 * 2;
constexpr size_t WS_YS = WS_Y + (size_t)PMAX * DM * 2;
constexpr size_t WS_FFN_END = WS_YS + (size_t)T * DM * 2;
static_assert(SH_FP8 == 1, "the combine phase reads the shared-expert output as fp8");
constexpr size_t WS_END = WS_MIX_END > WS_FFN_END ? WS_MIX_END : WS_FFN_END;
static_assert(WS_END <= (size_t)2100 * 1000 * 1000, "workspace must fit 4 x the largest tensor (2.147 GB)");
constexpr float W1_SCALE = 32.f, W2_SCALE = 16.f, Y_SCALE = 16.f;
#ifndef WIN_FP8
#define WIN_FP8 0
#endif
constexpr int WIN_B0 = 12, WIN_NB = 5;
#ifndef SH_FP8
#define SH_FP8 0
#endif
#ifndef WO_FP8
#define WO_FP8 0
#endif
constexpr int CW_CNT = 8192;

#define LDS_WAIT() asm volatile("s_waitcnt lgkmcnt(0)" ::: "memory")
#define VM_WAIT() asm volatile("s_waitcnt vmcnt(0)" ::: "memory")
#define SBAR() __builtin_amdgcn_sched_barrier(0)
__device__ __forceinline__ unsigned cvtpk(float lo, float hi) { unsigned r; asm volatile("v_cvt_pk_bf16_f32 %0, %1, %2" : "=v"(r) : "v"(lo), "v"(hi)); return r; }
__device__ __forceinline__ float bf2f(unsigned short b) { return __uint_as_float(((unsigned)b) << 16); }
__device__ __forceinline__ float bflo(unsigned w) { return __uint_as_float(w << 16); }
__device__ __forceinline__ float bfhi(unsigned w) { return __uint_as_float(w & 0xffff0000u); }
__device__ __forceinline__ unsigned short f2bf(float f) { return (unsigned short)(cvtpk(f, 0.f) & 0xffffu); }
__device__ __forceinline__ unsigned pk4_fp8(float a, float b, float c, float d) { int w = 0; w = __builtin_amdgcn_cvt_pk_fp8_f32(a, b, w, false); w = __builtin_amdgcn_cvt_pk_fp8_f32(c, d, w, true); return (unsigned)w; }
__device__ __forceinline__ float wave_sum(float v) {
    int x = __float_as_int(v);
#define WS_STEP(ctrl, rmask) x = __float_as_int(__int_as_float(x) + __int_as_float(__builtin_amdgcn_update_dpp(0, x, ctrl, rmask, 0xF, true)))
    WS_STEP(0xB1, 0xF);
    WS_STEP(0x4E, 0xF);
    WS_STEP(0x141, 0xF);
    WS_STEP(0x140, 0xF);
    WS_STEP(0x142, 0xA);
    WS_STEP(0x143, 0xC);
#undef WS_STEP
    return __int_as_float(__builtin_amdgcn_readlane(x, 63));
}
__device__ __forceinline__ int wave_sum_i(int x) {
#define WS_STEP(ctrl, rmask) x = x + __builtin_amdgcn_update_dpp(0, x, ctrl, rmask, 0xF, true)
    WS_STEP(0xB1, 0xF); WS_STEP(0x4E, 0xF); WS_STEP(0x141, 0xF); WS_STEP(0x140, 0xF); WS_STEP(0x142, 0xA); WS_STEP(0x143, 0xC);
#undef WS_STEP
    return __builtin_amdgcn_readlane(x, 63);
}
__device__ __forceinline__ bf16x8 pack8(f32x4 a, f32x4 b) {
    u32x4 w = {cvtpk(a[0], a[1]), cvtpk(a[2], a[3]), cvtpk(b[0], b[1]), cvtpk(b[2], b[3])};
    return *reinterpret_cast<bf16x8*>(&w);
}

#define XB_TMO      128
#define XB_XCNT(j)  (256  + 64 * (j))
#define XB_XSUB(j)  (1280 + 64 * (j))
#define XB_XGEN(j)  (2304 + 64 * (j))
#define XB_TOP      3328
#define XB_TOPGEN   3392
#define XCD_BAR_WORDS 3456
#define XB_SPIN_CAP (1u << 22)
__device__ __forceinline__ unsigned xb_ld(unsigned* p)              { return __hip_atomic_load(p, __ATOMIC_RELAXED, __HIP_MEMORY_SCOPE_AGENT); }
__device__ __forceinline__ unsigned xb_add(unsigned* p, unsigned v) { return __hip_atomic_fetch_add(p, v, __ATOMIC_RELAXED, __HIP_MEMORY_SCOPE_AGENT); }
__device__ __forceinline__ unsigned xb_xcc_id() { return (unsigned)__builtin_amdgcn_s_getreg((3 << 11) | 20) & 0xFu; }
#define XB_SPIN(cond, bar) do { unsigned _sp = 0; while (cond) { __builtin_amdgcn_s_sleep(1); \
    if ((++_sp & 255u) == 0u) { if (xb_ld(&(bar)[XB_TMO])) break; if (_sp > XB_SPIN_CAP) { atomicAdd(&(bar)[XB_TMO], 1u); break; } } } } while (0)
struct XcdBarrier { unsigned* bar; unsigned x; volatile LAS unsigned* st; };
__device__ __forceinline__ int lane_id() { int l; asm volatile("v_mbcnt_lo_u32_b32 %0, -1, 0\n\tv_mbcnt_hi_u32_b32 %0, -1, %0" : "=&v"(l)); return l; }
__device__ __forceinline__ XcdBarrier xcd_barrier_post(unsigned* bar, volatile LAS unsigned* st, int wave_s) {
    XcdBarrier b; b.bar = bar; b.x = xb_xcc_id(); b.st = st;
    if (wave_s == 0 && lane_id() == 0) (void)xb_add(&bar[XB_XCNT(b.x)], 1u);
    return b;
}
__device__ __forceinline__ void xcd_barrier_complete(unsigned* bar, unsigned x, unsigned& nloc, unsigned& nx) {
    const unsigned G = gridDim.x * gridDim.y * gridDim.z;
    unsigned sum, cnt, mine, sp = 0u;
    for (;;) {
        sum = 0u; cnt = 0u; mine = 0u;
#pragma unroll
        for (unsigned j = 0; j < 16; ++j) { const unsigned c = xb_ld(&bar[XB_XCNT(j)]); sum += c; cnt += (c > 0u) ? 1u : 0u; mine = (j == x) ? c : mine; }
        if (sum == G) break;
        __builtin_amdgcn_s_sleep(1);
        if ((++sp & 255u) == 0u) { if (xb_ld(&bar[XB_TMO])) break; if (sp > XB_SPIN_CAP) { atomicAdd(&bar[XB_TMO], 1u); break; } }
    }
    nloc = mine > 0u ? mine : 1u; nx = cnt > 0u ? cnt : 1u;
}
__device__ __forceinline__ void xcd_barrier(const XcdBarrier& b, int wave_s) {
    asm volatile("s_waitcnt vmcnt(0)" ::: "memory");
    __syncthreads();
    if (wave_s == 0 && lane_id() == 0) {
        unsigned* bar = b.bar;
        __builtin_amdgcn_s_waitcnt(0);
        unsigned nloc = b.st[0], nx = b.st[1];
        if (nloc == 0u) { xcd_barrier_complete(bar, b.x, nloc, nx); b.st[0] = nloc; b.st[1] = nx; }
        const unsigned old = xb_add(&bar[XB_XSUB(b.x)], 1u);
        const unsigned gen = old / nloc;
        if (old + 1u == (gen + 1u) * nloc) {
            __builtin_amdgcn_fence(__ATOMIC_RELEASE, "agent");
            asm volatile("s_waitcnt vmcnt(0)" ::: "memory");
            const unsigned og = xb_add(&bar[XB_TOP], 1u);
            const unsigned tg = og / nx;
            if (og + 1u == (tg + 1u) * nx) xb_add(&bar[XB_TOPGEN], 1u);
            else XB_SPIN(xb_ld(&bar[XB_TOPGEN]) == tg, bar);
            __builtin_amdgcn_fence(__ATOMIC_ACQUIRE, "agent");
            xb_add(&bar[XB_XGEN(b.x)], 1u);
            asm volatile("s_waitcnt vmcnt(0)" ::: "memory");
        } else {
            XB_SPIN(xb_ld(&bar[XB_XGEN(b.x)]) == gen, bar);
            __builtin_amdgcn_fence(__ATOMIC_ACQUIRE, "agent");
            asm volatile("s_waitcnt vmcnt(0)" ::: "memory");
        }
    }
    __syncthreads();
}

namespace pg8 {
typedef int i32x4v __attribute__((ext_vector_type(4)));
typedef int i32x8v __attribute__((ext_vector_type(8)));
constexpr int BM = 256, BK = 64, HALF = 128, HTB = HALF * BK * 2, STAGE_BYTES = 8 * HTB, NXCD = 8, WGM = 4;
__device__ __forceinline__ int lds_byte(int r, int c) { const int st = (r >> 4) * 2 + (c >> 5), rr = r & 15, cc = c & 31, ob = rr * 64 + cc * 2; return st * 1024 + (ob ^ (((ob >> 9) & 1) << 5)); }
__device__ __forceinline__ void stage_rc(int b, int& R, int& C) { const int st = b / 1024, sb = b % 1024, swz = sb ^ (((sb >> 9) & 1) << 5); R = (st >> 1) * 16 + swz / 64; C = (st & 1) * 32 + (swz % 64) / 2; }
__device__ __forceinline__ int perm32(int rho) { const int n = rho >> 4, i = rho & 15; return 8 * (i >> 2) + 4 * n + (i & 3); }

struct Unit { int row0, pn, e, slot0, vr; };

__device__ __forceinline__ int xcd_remap(int L, int nwg) {
    const int q = nwg / NXCD, r = nwg % NXCD, xcd = L % NXCD, off = L / NXCD;
    return (xcd < r ? xcd * (q + 1) : r * (q + 1) + (xcd - r) * q) + off;
}
struct DenseOrder {
    static constexpr bool GATHER = false;
    int nM, nN, nwg, G, c; unsigned lda2; const char* Bt; size_t bstep;
    int pn_cut = 1 << 30, pn_add = 0, pn_off = 0, pn_boff = 0;
    __device__ __forceinline__ void init(int M, int N, int K, int lda, const void* Bt_, int G_, int c_) { nM = M / BM; nN = N / BM; nwg = nM * nN; G = G_; c = c_; lda2 = (unsigned)lda * 2u; Bt = (const char*)Bt_; bstep = (size_t)BM * K * 2; }
    __device__ __forceinline__ bool next(int i, Unit& u) const {
        const long L = (long)i * G + c; if (L >= nwg) return false;
        const int wgid = xcd_remap((int)L, nwg);
        const int nig = WGM * nN, gid = wgid / nig, fm = gid * WGM, gsz = (nM - fm) < WGM ? (nM - fm) : WGM;
        const int pm = fm + ((wgid % nig) % gsz); int p = (wgid % nig) / gsz; p += pn_off + (p >= pn_cut ? pn_add : 0); u.pn = p; u.row0 = pm * BM; u.e = 0; u.slot0 = 0; u.vr = BM; return true;
    }
    __device__ __forceinline__ unsigned atok(const Unit& u, int r) const { return 0u; }
    __device__ __forceinline__ size_t abase(const Unit& u) const { return (size_t)u.row0 * lda2; }
    __device__ __forceinline__ const char* bptr(const Unit& u) const { return Bt + (size_t)(u.pn - pn_boff) * bstep; }
};
template <bool GATHER_>
struct GroupOrder {
    static constexpr bool GATHER = GATHER_;
    const LAS int* cnt; const LAS int* ptile; int ncol, nwg, G, c; unsigned lda2; const char* Bt; size_t bstep, estep; const int* slot_tok;
    __device__ __forceinline__ void init(const LAS int* cnt_, const LAS int* ptile_, int ncol_, int K, int lda, const void* Bt_, size_t estep_, const int* st, int G_, int c_) {
        cnt = cnt_; ptile = ptile_; ncol = ncol_; nwg = ptile_[NE] * ncol_; G = G_; c = c_; lda2 = (unsigned)lda * 2u; Bt = (const char*)Bt_; bstep = (size_t)BM * K * 2; estep = estep_; slot_tok = st; }
    __device__ __forceinline__ bool next(int i, Unit& u) const {
        const long L = (long)i * G + c; if (L >= nwg) return false;
        const int wgid = xcd_remap((int)L, nwg);
        const int p = wgid / ncol; u.pn = wgid - p * ncol;
        const int v = ptile[80 + p];
        u.e = v & 0xff; u.row0 = p * BM; u.slot0 = ((v >> 8) & 0xff) * BM; u.vr = v >> 16; return true;
    }
    __device__ __forceinline__ unsigned atok(const Unit& u, int r) const {
        const int rr = r < u.vr ? r : u.vr - 1, s = u.slot0 + rr; return (unsigned)slot_tok[(size_t)u.e * T + s];
    }
    __device__ __forceinline__ size_t abase(const Unit& u) const { return GATHER ? (size_t)0 : (size_t)u.row0 * lda2; }
    __device__ __forceinline__ const char* bptr(const Unit& u) const { return Bt + (size_t)u.e * estep + (size_t)u.pn * bstep; }
};

struct EpiBf16S {
    static constexpr bool PERM = true, STAGGER = false, DEFER = false; static constexpr int NPF = 0;
    bf16_t* O; int ldc; float sc;
    __device__ __forceinline__ void operator()(const f32x4 (&acc)[2][2][4][2], const Unit& u, int wr, int wc, int fr, int fq) const {
        const int row0 = u.row0 + wr * 64 + fr, col0 = u.pn * BM + wc * 32 + 8 * fq;
#pragma unroll
        for (int ai = 0; ai < 2; ++ai)
#pragma unroll
            for (int m = 0; m < 4; ++m) { bf16_t* rowp = O + (size_t)(row0 + ai * HALF + m * 16) * ldc + col0;
#pragma unroll
                for (int bj = 0; bj < 2; ++bj) { const f32x4 v0 = acc[ai][bj][m][0] * sc, v1 = acc[ai][bj][m][1] * sc;
                    u32x4 w; w.x = cvtpk(v0[0], v0[1]); w.y = cvtpk(v0[2], v0[3]); w.z = cvtpk(v1[0], v1[1]); w.w = cvtpk(v1[2], v1[3]);
                    *(u32x4*)(rowp + bj * HALF) = w; } }
    }
};
struct EpiFp8S {
    static constexpr bool PERM = true, STAGGER = (STAGGER_SLEEP > 0), DEFER = (DEFER_STORE != 0); static constexpr int NPF = 0;
    unsigned char* O; int ldc; float sc;
    __device__ __forceinline__ void operator()(const f32x4 (&acc)[2][2][4][2], const Unit& u, int wr, int wc, int fr, int fq) const {
#if Y_TILED
        unsigned char* tileb = O + ((size_t)(u.row0 >> 8) * (DM / BM) + u.pn) * (size_t)(BM * BM) + (size_t)(wr * 64 + fr) * BM + wc * 64 + 16 * fq;
#else
        const int row0 = u.row0 + wr * 64 + fr, col0 = u.pn * BM + wc * 64 + 16 * fq;
#endif
#pragma unroll
        for (int ai = 0; ai < 2; ++ai)
#pragma unroll
            for (int m = 0; m < 4; ++m) {
#if Y_TILED
                unsigned char* rowp = tileb + (ai * HALF + m * 16) * BM;
#else
                unsigned char* rowp = O + (size_t)(row0 + ai * HALF + m * 16) * ldc + col0;
#endif
                f32x4 a0 = acc[ai][0][m][0], a1 = acc[ai][0][m][1], b0 = acc[ai][1][m][0], b1 = acc[ai][1][m][1];
                if constexpr (Y_SCALE != W2_SCALE) { a0 = a0 * sc; a1 = a1 * sc; b0 = b0 * sc; b1 = b1 * sc; }
                u32x4 w; w.x = pk4_fp8(a0[0], a0[1], a0[2], a0[3]); w.y = pk4_fp8(a1[0], a1[1], a1[2], a1[3]); w.z = pk4_fp8(b0[0], b0[1], b0[2], b0[3]); w.w = pk4_fp8(b1[0], b1[1], b1[2], b1[3]);
#ifdef Y_NT_STORE
                __builtin_nontemporal_store(w, (u32x4*)rowp); }
#else
                *(u32x4*)rowp = w; }
#endif
    }
    __device__ __forceinline__ u32x4 pack_row(const f32x4 (&acc)[2][2][4][2], int ai, int m) const {
        f32x4 a0 = acc[ai][0][m][0], a1 = acc[ai][0][m][1], b0 = acc[ai][1][m][0], b1 = acc[ai][1][m][1];
        if constexpr (Y_SCALE != W2_SCALE) { a0 = a0 * sc; a1 = a1 * sc; b0 = b0 * sc; b1 = b1 * sc; }
        u32x4 w; w.x = pk4_fp8(a0[0], a0[1], a0[2], a0[3]); w.y = pk4_fp8(a1[0], a1[1], a1[2], a1[3]); w.z = pk4_fp8(b0[0], b0[1], b0[2], b0[3]); w.w = pk4_fp8(b1[0], b1[1], b1[2], b1[3]);
        return w;
    }
    __device__ __forceinline__ void pack(const f32x4 (&acc)[2][2][4][2], u32x4 (&pend)[4]) const {
#pragma unroll
        for (int m = 0; m < 4; ++m) pend[m] = pack_row(acc, 0, m);
    }
    __device__ __forceinline__ void store_all(const f32x4 (&acc)[2][2][4][2], const u32x4 (&pend)[4], int urow0, int upn, int wr, int wc, int fr, int fq) const {
        const int row0 = urow0 + wr * 64 + fr, col0 = upn * BM + wc * 64 + 16 * fq;
#pragma unroll
        for (int m = 0; m < 4; ++m) *(u32x4*)(O + (size_t)(row0 + m * 16) * ldc + col0) = pend[m];
#pragma unroll
        for (int m = 0; m < 4; ++m) *(u32x4*)(O + (size_t)(row0 + HALF + m * 16) * ldc + col0) = pack_row(acc, 1, m);
    }
};
template <bool XBF>
struct EpiResidT {
    static constexpr bool PERM = true, STAGGER = false, DEFER = false;
    static constexpr int NPF = (RESID_PREFETCH != 0) ? (XBF ? 2 : 4) : 0;
    const void* xin; bf16_t* xout; const float* gate; float sc;
    __device__ __forceinline__ void prefetch(const Unit& u, int tid, unsigned& pf) const {
        constexpr int ES = XBF ? 2 : 4, LPR = BM * ES / 128;
        const unsigned char* base = (const unsigned char*)xin + ((size_t)u.row0 * DM + (size_t)u.pn * BM) * ES;
        unsigned off[4];
#pragma unroll
        for (int i = 0; i < 4; ++i) { const int line = tid + 512 * (i < NPF ? i : 0), row = line / LPR, seg = line % LPR; off[i] = (unsigned)row * (unsigned)(DM * ES) + (unsigned)seg * 128u; }
        if constexpr (NPF == 2) asm volatile("global_load_dword %0, %1, %3\n\tglobal_load_dword %0, %2, %3" : "=&v"(pf) : "v"(off[0]), "v"(off[1]), "s"(base) : "memory");
        else asm volatile("global_load_dword %0, %1, %5\n\tglobal_load_dword %0, %2, %5\n\tglobal_load_dword %0, %3, %5\n\tglobal_load_dword %0, %4, %5" : "=&v"(pf) : "v"(off[0]), "v"(off[1]), "v"(off[2]), "v"(off[3]), "s"(base) : "memory");
    }
    __device__ __forceinline__ void operator()(const f32x4 (&acc)[2][2][4][2], const Unit& u, int wr, int wc, int fr, int fq) const {
        const int row0 = u.row0 + wr * 64 + fr, col0 = u.pn * BM + wc * 32 + 8 * fq;
        const float* gb = gate + (size_t)(u.row0 / SEQ) * (6 * DM) + col0;
        f32x4 gv[2][2];
#pragma unroll
        for (int bj = 0; bj < 2; ++bj)
#pragma unroll
            for (int n = 0; n < 2; ++n) gv[bj][n] = *(const f32x4*)(gb + bj * HALF + 4 * n) * sc;
#pragma unroll
        for (int ai = 0; ai < 2; ++ai)
#pragma unroll
            for (int m = 0; m < 4; ++m) { const size_t off = (size_t)(row0 + ai * HALF + m * 16) * DM + col0;
#pragma unroll
                for (int bj = 0; bj < 2; ++bj) { f32x4 x0, x1;
                    if constexpr (XBF) { const u32x4 w = *(const u32x4*)((const bf16_t*)xin + off + bj * HALF); x0 = (f32x4){bflo(w.x), bfhi(w.x), bflo(w.y), bfhi(w.y)}; x1 = (f32x4){bflo(w.z), bfhi(w.z), bflo(w.w), bfhi(w.w)}; }
                    else { x0 = *(const f32x4*)((const float*)xin + off + bj * HALF); x1 = *(const f32x4*)((const float*)xin + off + bj * HALF + 4); }
                    x0 = x0 + gv[bj][0] * acc[ai][bj][m][0]; x1 = x1 + gv[bj][1] * acc[ai][bj][m][1];
                    u32x4 o; o.x = cvtpk(x0[0], x0[1]); o.y = cvtpk(x0[2], x0[3]); o.z = cvtpk(x1[0], x1[1]); o.w = cvtpk(x1[2], x1[3]);
                    *(u32x4*)(xout + off + bj * HALF) = o; } }
    }
};
__device__ __forceinline__ float silu_mul(float g, float u) { return g * __builtin_amdgcn_rcpf(1.f + __builtin_amdgcn_exp2f(-1.4426950408889634f * g)) * u; }
template <bool OUT8>
struct EpiSwigluT {
    static constexpr int NPF = 0;
    static constexpr bool STAGGER = false, DEFER = false;
    static constexpr bool PERM = true;
    bf16_t* O; int ldc; float sc;
    __device__ __forceinline__ void operator()(const f32x4 (&acc)[2][2][4][2], const Unit& u, int wr, int wc, int fr, int fq) const {
        const int row0 = u.row0 + wr * 64 + fr, col0 = u.pn * HALF + wc * 32 + 8 * fq;
        if constexpr (OUT8) {
            const int colb = u.pn * HALF + wc * 32 + 16 * (fq >> 1);
#pragma unroll
            for (int ai = 0; ai < 2; ++ai)
#pragma unroll
                for (int m = 0; m < 4; m += 2) {
                    unsigned px[2], py[2];
#pragma unroll
                    for (int q = 0; q < 2; ++q) { const f32x4 g0 = acc[ai][0][m + q][0] * sc, g1 = acc[ai][0][m + q][1] * sc, u0 = acc[ai][1][m + q][0] * sc, u1 = acc[ai][1][m + q][1] * sc;
                        px[q] = pk4_fp8(silu_mul(g0[0], u0[0]), silu_mul(g0[1], u0[1]), silu_mul(g0[2], u0[2]), silu_mul(g0[3], u0[3]));
                        py[q] = pk4_fp8(silu_mul(g1[0], u1[0]), silu_mul(g1[1], u1[1]), silu_mul(g1[2], u1[2]), silu_mul(g1[3], u1[3])); }
                    const auto sx = __builtin_amdgcn_permlane16_swap(px[0], px[1], false, false), sy = __builtin_amdgcn_permlane16_swap(py[0], py[1], false, false);
                    u32x4 w; w.x = sx[0]; w.y = sy[0]; w.z = sx[1]; w.w = sy[1];
                    *(u32x4*)((unsigned char*)O + (size_t)(row0 + ai * HALF + (m + (fq & 1)) * 16) * ldc + colb) = w; }
        } else {
#pragma unroll
        for (int ai = 0; ai < 2; ++ai)
#pragma unroll
            for (int m = 0; m < 4; ++m) { bf16_t* rowp = O + (size_t)(row0 + ai * HALF + m * 16) * ldc + col0;
                const f32x4 g0 = acc[ai][0][m][0] * sc, g1 = acc[ai][0][m][1] * sc, u0 = acc[ai][1][m][0] * sc, u1 = acc[ai][1][m][1] * sc;
                u32x4 w; w.x = cvtpk(silu_mul(g0[0], u0[0]), silu_mul(g0[1], u0[1])); w.y = cvtpk(silu_mul(g0[2], u0[2]), silu_mul(g0[3], u0[3]));
                w.z = cvtpk(silu_mul(g1[0], u1[0]), silu_mul(g1[1], u1[1])); w.w = cvtpk(silu_mul(g1[2], u1[2]), silu_mul(g1[3], u1[3]));
                *(u32x4*)rowp = w; }
        }
    }
};

typedef EpiSwigluT<false> EpiSwiglu;
typedef EpiSwigluT<true> EpiSwiglu8;
template <class Epi, class Sched, bool FP8 = false>
__device__ __forceinline__ void gemm_phase(LAS unsigned char* lds, const int tid, const char* Abase, int K, const Sched& S, const Epi& E) {
    const int wid = __builtin_amdgcn_readfirstlane(tid >> 6), lane = tid & 63, wr = wid >> 2, wc = wid & 3, fr = lane & 15, fq = lane >> 4;
    const int nt = K / BK;
    constexpr bool GA = Sched::GATHER;
    int Rr[2], Cc2[2]; unsigned voffB[2], voffA[2];
#pragma unroll
    for (int i = 0; i < 2; ++i) { int R, C; stage_rc(tid * 16 + i * 8192, R, C); const int Rb = Epi::PERM ? ((R & ~31) + perm32(R & 31)) : R;
        Rr[i] = R; Cc2[i] = C * 2; voffB[i] = (unsigned)(Rb * K + C) * 2u; voffA[i] = (unsigned)R * S.lda2 + (unsigned)C * 2u; }
    const size_t hstepA = (size_t)HALF * S.lda2;
    const size_t kstep = (size_t)(BK * 2);
    const size_t hstep = (size_t)HALF * K * 2;
    const unsigned ldsw = (unsigned)wid * 1024u;
    const int aoff = lds_byte(wr * 64 + fr, fq * 8), boff = lds_byte(wc * 32 + fr, fq * 8);
#define PG8_SA(b, h) (((b) * 2 + (h)) * HTB)
#define PG8_SB(b, h) ((4 + (b) * 2 + (h)) * HTB)
#define PG8_STAGE(bufoff, gbase, voff) do { _Pragma("unroll") for (int _i = 0; _i < 2; ++_i) \
        __builtin_amdgcn_global_load_lds((const unsigned*)((const char*)(gbase) + (voff)[_i]), (LAS unsigned*)(lds + (bufoff) + ldsw + _i * 8192), 16, 0, 0); } while (0)
#define PG8_LDA(dst, b, h) do { _Pragma("unroll") for (int m = 0; m < 4; ++m) _Pragma("unroll") for (int k = 0; k < 2; ++k) dst[m][k] = *(const LAS bf16x8*)(lds + PG8_SA(b, h) + aoff + m * 2048 + k * 1024); } while (0)
#define PG8_LDB(dst, b, h) do { _Pragma("unroll") for (int n = 0; n < 2; ++n) _Pragma("unroll") for (int k = 0; k < 2; ++k) dst[n][k] = *(const LAS bf16x8*)(lds + PG8_SB(b, h) + boff + n * 2048 + k * 1024); } while (0)
#define PG8_MMA(ai, bj, At, Bt) do { __builtin_amdgcn_s_setprio(1); _Pragma("unroll") for (int m = 0; m < 4; ++m) _Pragma("unroll") for (int n = 0; n < 2; ++n) _Pragma("unroll") for (int k = 0; k < 2; ++k) \
        acc[ai][bj][m][n] = __builtin_amdgcn_mfma_f32_16x16x32_bf16(Bt[n][k], At[m][k], acc[ai][bj][m][n], 0, 0, 0); __builtin_amdgcn_s_setprio(0); } while (0)
#define PG8_CAT8(lo, hi) __builtin_shufflevector(lo, hi, 0, 1, 2, 3, 4, 5, 6, 7)
#define PG8_LDA8(dst, b, h) do { _Pragma("unroll") for (int m = 0; m < 4; ++m) { const i32x4v lo_ = *(const LAS i32x4v*)(lds + PG8_SA(b, h) + aoff + m * 2048), hi_ = *(const LAS i32x4v*)(lds + PG8_SA(b, h) + aoff + m * 2048 + 1024); dst[m] = PG8_CAT8(lo_, hi_); } } while (0)
#define PG8_LDB8(dst, b, h) do { _Pragma("unroll") for (int n = 0; n < 2; ++n) { const i32x4v lo_ = *(const LAS i32x4v*)(lds + PG8_SB(b, h) + boff + n * 2048), hi_ = *(const LAS i32x4v*)(lds + PG8_SB(b, h) + boff + n * 2048 + 1024); dst[n] = PG8_CAT8(lo_, hi_); } } while (0)
#define PG8_MMA8(ai, bj, A8, B8) do { __builtin_amdgcn_s_setprio(1); _Pragma("unroll") for (int m = 0; m < 4; ++m) _Pragma("unroll") for (int n = 0; n < 2; ++n) \
        asm volatile("v_mfma_scale_f32_16x16x128_f8f6f4 %0, %1, %2, %0, %3, %3 op_sel_hi:[0,0,0]" : "+v"(acc[ai][bj][m][n]) : "v"(B8[n]), "v"(A8[m]), "v"(one8)); __builtin_amdgcn_s_setprio(0); } while (0)
#define PG8_MMA8Z(ai, bj, A8, B8) do { __builtin_amdgcn_s_setprio(1); _Pragma("unroll") for (int m = 0; m < 4; ++m) _Pragma("unroll") for (int n = 0; n < 2; ++n) \
        asm volatile("v_mfma_scale_f32_16x16x128_f8f6f4 %0, %1, %2, 0, %3, %3 op_sel_hi:[0,0,0]" : "=&v"(acc[ai][bj][m][n]) : "v"(B8[n]), "v"(A8[m]), "v"(one8)); __builtin_amdgcn_s_setprio(0); } while (0)
#define PG8_LA(b, h) do { if constexpr (FP8) PG8_LDA8(A8, b, h); else PG8_LDA(At, b, h); } while (0)
#define PG8_LB0(b, h) do { if constexpr (FP8) PG8_LDB8(B08, b, h); else PG8_LDB(B0, b, h); } while (0)
#define PG8_LB1(b, h) do { if constexpr (FP8) PG8_LDB8(B18, b, h); else PG8_LDB(B1, b, h); } while (0)
#define PG8_MM0(ai, bj) do { if constexpr (FP8) PG8_MMA8(ai, bj, A8, B08); else PG8_MMA(ai, bj, At, B0); } while (0)
#define PG8_MM1(ai, bj) do { if constexpr (FP8) PG8_MMA8(ai, bj, A8, B18); else PG8_MMA(ai, bj, At, B1); } while (0)
#define PG8_MM0F(ai, bj) do { if constexpr (FP8) { if (t == 0) PG8_MMA8Z(ai, bj, A8, B08); else PG8_MMA8(ai, bj, A8, B08); } else PG8_MMA(ai, bj, At, B0); } while (0)
#define PG8_MM1F(ai, bj) do { if constexpr (FP8) { if (t == 0) PG8_MMA8Z(ai, bj, A8, B18); else PG8_MMA8(ai, bj, A8, B18); } else PG8_MMA(ai, bj, At, B1); } while (0)
#define PG8_WAIT_V(n) asm volatile("s_waitcnt vmcnt(" #n ")" ::: "memory")
#if JIT_WAITS
#define PG8_JW do { if constexpr (!Epi::DEFER) asm volatile("s_waitcnt vmcnt(10)" ::: "memory"); } while (0)
#define PG8_WAIT_VM asm volatile("s_waitcnt vmcnt(10)" ::: "memory")
#else
#define PG8_JW do { } while (0)
#define PG8_WAIT_VM asm volatile("s_waitcnt vmcnt(6)" ::: "memory")
#endif
#define PG8_WAIT_L(n) asm volatile("s_waitcnt lgkmcnt(" #n ")" ::: "memory")
#define PG8_BAR __builtin_amdgcn_s_barrier()
#define PG8_SCHED __builtin_amdgcn_sched_barrier(0)
    Unit cur, nxt; int ui = 0;
    if (!S.next(0, cur)) return;
    unsigned pfv = 0u;
    u32x4 pend[4]; int pend_row0 = 0, pend_pn = 0; bool have_pend = false;
    if constexpr (Epi::STAGGER) { for (int g = ((S.c >> 3) & 7) + ((S.c >> 6) & 3); g > 0; --g) __builtin_amdgcn_s_sleep(STAGGER_SLEEP); }
    f32x4 acc[2][2][4][2];
    if constexpr (!FP8)
#pragma unroll
    for (int a = 0; a < 2; ++a)
#pragma unroll
        for (int b = 0; b < 2; ++b)
#pragma unroll
            for (int m = 0; m < 4; ++m)
#pragma unroll
                for (int n = 0; n < 2; ++n) acc[a][b][m][n] = (f32x4){0.f, 0.f, 0.f, 0.f};
    bf16x8 At[4][2], B0[2][2], B1[2][2];
    i32x8v A8[4], B08[2], B18[2];
    const int one8 = 0x7F7F7F7F;
    unsigned pkL[2] = {0u, 0u};
    unsigned pkC[2], tn0[2], tn1[2];
#pragma unroll
    for (int i = 0; i < 2; ++i) { if constexpr (GA) pkC[i] = S.atok(cur, Rr[i]) | (S.atok(cur, HALF + Rr[i]) << 16); else pkC[i] = 0u; tn0[i] = pkC[i] & 0xffffu; tn1[i] = pkC[i] >> 16; }
#define PG8_AOFF(dst, pk, hsel) do { _Pragma("unroll") for (int _j = 0; _j < 2; ++_j) { if constexpr (GA) dst[_j] = ((hsel) ? ((pk)[_j] >> 16) : ((pk)[_j] & 0xffffu)) * S.lda2 + (unsigned)Cc2[_j]; else dst[_j] = voffA[_j]; } } while (0)
    unsigned vC0[2], vC1[2]; PG8_AOFF(vC0, pkC, 0); PG8_AOFF(vC1, pkC, 1);
    const char* cB = S.bptr(cur);
    const char* cA = Abase + S.abase(cur);
    const size_t hA = GA ? (size_t)0 : hstepA;
    PG8_STAGE(PG8_SB(0, 0), cB, voffB); PG8_STAGE(PG8_SA(0, 0), cA, vC0); PG8_STAGE(PG8_SB(0, 1), cB + hstep, voffB); PG8_STAGE(PG8_SA(0, 1), cA + hA, vC1);
    if (wr == 1) PG8_BAR;
    PG8_WAIT_V(4); PG8_BAR;
    PG8_STAGE(PG8_SB(1, 0), cB + kstep, voffB); PG8_STAGE(PG8_SA(1, 0), cA + kstep, vC0); PG8_STAGE(PG8_SB(1, 1), cB + hstep + kstep, voffB);
    PG8_WAIT_V(6); PG8_BAR;
    for (;;) {
        const bool has_next = S.next(ui + 1, nxt);
        const char* nB = has_next ? S.bptr(nxt) : cB;
        const char* nA = has_next ? Abase + S.abase(nxt) : cA;
        if constexpr (GA) {
#pragma unroll
            for (int i = 0; i < 2; ++i) { if (has_next) { tn0[i] = S.atok(nxt, Rr[i]); tn1[i] = S.atok(nxt, HALF + Rr[i]); } }
        }
        for (int t = 0; t < nt; t += 2) {
            const bool last = (t == nt - 2);
            const char* a1 = cA + (size_t)(t + 1) * kstep;
            const char* a2 = last ? nA : cA + (size_t)(t + 2) * kstep; const char* b2 = last ? nB : cB + (size_t)(t + 2) * kstep;
            const char* a3 = a2 + kstep; const char* b3 = b2 + kstep;
            unsigned pks[2], w0[2], w1[2], c1[2];
            if constexpr (GA) { if (last) { asm volatile("" : "+v"(tn0[0]), "+v"(tn0[1]), "+v"(tn1[0]), "+v"(tn1[1]));
                                         pkL[0] = tn0[0] | (tn1[0] << 16); pkL[1] = tn0[1] | (tn1[1] << 16); pks[0] = pkL[0]; pks[1] = pkL[1]; } else { pks[0] = pkC[0]; pks[1] = pkC[1]; } }
            else { pks[0] = 0u; pks[1] = 0u; }
            PG8_AOFF(c1, pkC, 1);
            PG8_LB0(0, 0); PG8_SCHED; PG8_LA(0, 0); PG8_STAGE(PG8_SA(1, 1), a1 + hA, c1);
            PG8_JW; PG8_WAIT_L(8); PG8_BAR; PG8_WAIT_L(0); PG8_MM0F(0, 0); PG8_BAR; PG8_SCHED;
            if constexpr (Epi::DEFER) { if (t == 0 && have_pend) { E.store_all(acc, pend, pend_row0, pend_pn, wr, wc, fr, fq); PG8_SCHED; } }
            PG8_LB1(0, 1); PG8_STAGE(PG8_SB(0, 0), b2, voffB);
            PG8_JW; PG8_BAR; PG8_WAIT_L(0); PG8_MM1F(0, 1); PG8_BAR;
            PG8_LA(0, 1); PG8_AOFF(w0, pks, 0); PG8_STAGE(PG8_SA(0, 0), a2, w0);
            PG8_BAR; PG8_WAIT_L(0); PG8_MM0F(1, 0); PG8_BAR; PG8_SCHED;
            PG8_STAGE(PG8_SB(0, 1), b2 + hstep, voffB);
            if constexpr (Epi::DEFER) { if (t == 0 && have_pend) PG8_WAIT_V(14); else PG8_WAIT_V(6); } else PG8_WAIT_VM;
            PG8_BAR; PG8_MM1F(1, 1); PG8_BAR;
            if constexpr (Epi::NPF > 0) { if (last) { E.prefetch(cur, tid, pfv); PG8_SCHED; } }
            PG8_LB0(1, 0); PG8_SCHED; PG8_LA(1, 0); PG8_AOFF(w1, pks, 1); PG8_STAGE(PG8_SA(0, 1), a2 + hA, w1);
            PG8_JW; PG8_WAIT_L(8); PG8_BAR; PG8_WAIT_L(0); PG8_MM0(0, 0); PG8_BAR; PG8_SCHED;
            PG8_LB1(1, 1); PG8_STAGE(PG8_SB(1, 0), b3, voffB);
            PG8_JW; PG8_BAR; PG8_WAIT_L(0); PG8_MM1(0, 1); PG8_BAR;
            PG8_LA(1, 1); PG8_AOFF(w0, pks, 0); PG8_STAGE(PG8_SA(1, 0), a3, w0);
            PG8_BAR; PG8_WAIT_L(0); PG8_MM0(1, 0); PG8_BAR; PG8_SCHED;
            PG8_STAGE(PG8_SB(1, 1), b3 + hstep, voffB);
            PG8_WAIT_VM; PG8_BAR; PG8_MM1(1, 1); PG8_BAR;
        }
#if ALIGN_EPI
        if constexpr (FP8) { if (wr == 0) PG8_BAR; }
#endif
        if constexpr (FP8) asm volatile("s_nop 15\n\ts_nop 15" ::: "memory");
        if constexpr (Epi::NPF > 0) asm volatile("" :: "v"(pfv));
        if constexpr (Epi::DEFER) { if (has_next) { E.pack(acc, pend); pend_row0 = cur.row0; pend_pn = cur.pn; have_pend = true; } else E(acc, cur, wr, wc, fr, fq); }
        else E(acc, cur, wr, wc, fr, fq);
#ifdef PROBE_EPI2
        if constexpr (FP8 && !Sched::GATHER) { asm volatile("" ::: "memory"); E(acc, cur, wr, wc, fr, fq); }
#endif
#if ALIGN_EPI
        if constexpr (FP8) { if (wr == 1) PG8_BAR; }
#endif
        if (!has_next) break;
        if constexpr (!FP8)
#pragma unroll
        for (int a = 0; a < 2; ++a)
#pragma unroll
            for (int b = 0; b < 2; ++b)
#pragma unroll
                for (int m = 0; m < 4; ++m)
#pragma unroll
                    for (int n = 0; n < 2; ++n) acc[a][b][m][n] = (f32x4){0.f, 0.f, 0.f, 0.f};
        cur = nxt; cB = nB; cA = nA; ++ui;
        if constexpr (GA) {
#pragma unroll
            for (int i = 0; i < 2; ++i) pkC[i] = pkL[i];
        }
    }
    PG8_WAIT_V(0);
    if (wr == 0) PG8_BAR;
    PG8_BAR;
#undef PG8_AOFF
#undef PG8_SA
#undef PG8_SB
#undef PG8_STAGE
#undef PG8_LDA
#undef PG8_LDB
#undef PG8_MMA
#undef PG8_MMA8
#undef PG8_CAT8
#undef PG8_LDA8
#undef PG8_LDB8
#undef PG8_LA
#undef PG8_LB0
#undef PG8_LB1
#undef PG8_MM0
#undef PG8_MM1
#undef PG8_WAIT_V
#undef PG8_WAIT_L
#undef PG8_BAR
#undef PG8_SCHED
}
}

struct Args { const float* in[23]; float* out; unsigned char* ws; int ph_lo, ph_hi; };
typedef const __attribute__((address_space(4))) Args* ArgsP;
struct Ctx {
    ArgsP ap; float* out; unsigned char* ws;
    char* lds;
    LAS unsigned char* ldsl;
    int tid, lane, wave, G, bid, gw, NGW, vcu;
};
__device__ __forceinline__ void ctx_init(Ctx& C, unsigned char* lds, int wave_s) {
    int tid = wave_s * 64 + lane_id(), bid = blockIdx.x, G = gridDim.x;
    asm volatile("" : "+v"(tid)); asm volatile("" : "+s"(bid)); asm volatile("" : "+s"(G));
    ArgsP ap = (ArgsP)__builtin_amdgcn_kernarg_segment_ptr(); asm volatile("" : "+s"(ap));
    unsigned lb = 0u; asm volatile("" : "+s"(lb));
    C.ap = ap; C.out = ap->out; C.ws = ap->ws; C.lds = (char*)lds + lb; C.ldsl = (LAS unsigned char*)lds + lb;
    C.tid = tid; C.lane = tid & 63; C.wave = __builtin_amdgcn_readfirstlane(tid >> 6); C.G = G; C.bid = bid;
    C.gw = bid * NWAVES + C.wave; C.NGW = G * NWAVES;
    C.vcu = (G % 8 == 0) ? (bid % 8) * (G / 8) + bid / 8 : bid;
}
enum { I_X = 0, I_C, I_POS, I_NMG, I_NFG, I_WADA, I_BADA, I_WIN, I_GCQ, I_GCKV, I_WUQ, I_WUKV, I_GOUT, I_WO, I_WR, I_BR, I_WG, I_WU, I_WD, I_WSG, I_WSU, I_WSD, I_FG };

__device__ __forceinline__ void cvt_tile(const float* W, int ldw, int ncols, int k0, int n0, bf16_t* WT, int ldt, int dst_row0, LAS float* scr, int lane) {
    f32x4 v[16];
    const int kr = lane >> 4, nc = (lane & 15) * 4;
    const bool ok = (n0 + nc) < ncols;
#pragma unroll
    for (int i = 0; i < 16; ++i) v[i] = ok ? __builtin_nontemporal_load((const f32x4*)(W + (size_t)(k0 + kr + 4 * i) * ldw + n0 + nc)) : (f32x4){0.f, 0.f, 0.f, 0.f};
#pragma unroll
    for (int i = 0; i < 16; ++i) { LAS float* s = scr + (kr + 4 * i) * 65 + nc; s[0] = v[i][0]; s[1] = v[i][1]; s[2] = v[i][2]; s[3] = v[i][3]; }
    LDS_WAIT();
    const int c = lane >> 3, nn = lane & 7;
#pragma unroll
    for (int j = 0; j < 8; ++j) { const int n = nn + 8 * j; const LAS float* s = scr + (8 * c) * 65 + n;
        u32x4 o; o.x = cvtpk(s[0], s[65]); o.y = cvtpk(s[2 * 65], s[3 * 65]); o.z = cvtpk(s[4 * 65], s[5 * 65]); o.w = cvtpk(s[6 * 65], s[7 * 65]);
        *(u32x4*)(WT + (size_t)(dst_row0 + n) * ldt + k0 + 8 * c) = o; }
    LDS_WAIT();
}
template <bool IL = false>
__device__ __forceinline__ void cvt_tile_f8(const float* W, int ldw, int ncols, int k0, int n0, unsigned char* WT8, int ldt, int dst_row0, float scale, LAS float* scr, int lane) {
    f32x4 v[16];
    const int kr = lane >> 4, nc = (lane & 15) * 4;
    const bool ok = (n0 + nc) < ncols;
#pragma unroll
    for (int i = 0; i < 16; ++i) v[i] = ok ? __builtin_nontemporal_load((const f32x4*)(W + (size_t)(k0 + kr + 4 * i) * ldw + n0 + nc)) : (f32x4){0.f, 0.f, 0.f, 0.f};
#pragma unroll
    for (int i = 0; i < 16; ++i) { LAS float* s = scr + (kr + 4 * i) * 65 + nc; s[0] = v[i][0]; s[1] = v[i][1]; s[2] = v[i][2]; s[3] = v[i][3]; }
    LDS_WAIT();
    const int c = lane >> 3, nn = lane & 7;
#pragma unroll
    for (int j = 0; j < 8; ++j) { const int n = nn + 8 * j; const LAS float* s = scr + (8 * c) * 65 + n;
        u32x2 o; o.x = pk4_fp8(s[0] * scale, s[65] * scale, s[2 * 65] * scale, s[3 * 65] * scale); o.y = pk4_fp8(s[4 * 65] * scale, s[5 * 65] * scale, s[6 * 65] * scale, s[7 * 65] * scale);
        const int drow = IL ? (dst_row0 + (j & 1) * 128 + 8 * (j >> 1) + nn) : (dst_row0 + n);
        *(u32x2*)(WT8 + (size_t)drow * ldt + k0 + 8 * c) = o; }
    LDS_WAIT();
}
__device__ __forceinline__ int gu_row(int n0, int up) { return (n0 >> 7) * 256 + up * 128 + (n0 & 127); }

constexpr int I_IN = 32 * 68, I_UQ = 8 * 24, I_UKV = 4 * 32, I_O = 32 * 32, I_SG = 32 * 8, I_SD = 8 * 32, I_RT = 32, I_EG = 32 * 8, I_ED = 8 * 32;
constexpr int I_SMALL = I_IN + I_UQ + I_UKV + I_O + 2 * I_SG + I_SD + I_RT;
constexpr int I_EXP = NE * (2 * I_EG + I_ED);
__device__ __forceinline__ void cvt_small_item(const Ctx& C, int l, int r, LAS float* scr) {
    unsigned char* wl = C.ws + WS_W + (size_t)l * LW_BYTES;
    if (r < I_IN) { const int kt = r / 68, ntl = r % 68; const int ct = ntl >> 2;
                    const bool f8 = (WIN_FP8 == 1) || (WIN_FP8 == 2 && (ct < WIN_B0 || ct >= WIN_B0 + WIN_NB));
                    if (f8) cvt_tile_f8(C.ap->in[I_WIN] + (size_t)l * DM * INW, INW, INW, kt * 64, ntl * 64, wl + LW_IN, DM, ntl * 64, W1_SCALE, scr, C.lane);
                    else if (WIN_FP8 == 2) cvt_tile(C.ap->in[I_WIN] + (size_t)l * DM * INW, INW, INW, kt * 64, ntl * 64, (bf16_t*)(wl + LW_IN + (size_t)NPROJ * DM), DM, ntl * 64 - WIN_B0 * 256, scr, C.lane);
                    else cvt_tile(C.ap->in[I_WIN] + (size_t)l * DM * INW, INW, INW, kt * 64, ntl * 64, (bf16_t*)(wl + LW_IN), DM, ntl * 64, scr, C.lane); return; } r -= I_IN;
    if (r < I_UQ) { const int kt = r / 24, ntl = r % 24; if (UQ_FP8) cvt_tile_f8(C.ap->in[I_WUQ] + (size_t)l * 512 * 1536, 1536, 1536, kt * 64, ntl * 64, wl + LW_UQ, 512, ntl * 64, W1_SCALE, scr, C.lane);
                    else cvt_tile(C.ap->in[I_WUQ] + (size_t)l * 512 * 1536, 1536, 1536, kt * 64, ntl * 64, (bf16_t*)(wl + LW_UQ), 512, ntl * 64, scr, C.lane); return; } r -= I_UQ;
    if (r < I_UKV) { const int kt = r / 32, ntl = r % 32; if (UKV_FP8) cvt_tile_f8(C.ap->in[I_WUKV] + (size_t)l * 256 * 2048, 2048, 2048, kt * 64, ntl * 64, wl + LW_UKV, 256, ntl * 64, W1_SCALE, scr, C.lane);
                     else cvt_tile(C.ap->in[I_WUKV] + (size_t)l * 256 * 2048, 2048, 2048, kt * 64, ntl * 64, (bf16_t*)(wl + LW_UKV), 256, ntl * 64, scr, C.lane); return; } r -= I_UKV;
    if (r < I_O) { const int kt = r / 32, ntl = r % 32; if (WO_FP8) cvt_tile_f8(C.ap->in[I_WO] + (size_t)l * DM * DM, DM, DM, kt * 64, ntl * 64, wl + LW_O, DM, ntl * 64, W1_SCALE, scr, C.lane);
                    else cvt_tile(C.ap->in[I_WO] + (size_t)l * DM * DM, DM, DM, kt * 64, ntl * 64, (bf16_t*)(wl + LW_O), DM, ntl * 64, scr, C.lane); return; } r -= I_O;
    if (r < I_SG) { const int kt = r / 8, ntl = r % 8; if (SH_FP8) cvt_tile_f8(C.ap->in[I_WSG] + (size_t)l * DM * 512, 512, 512, kt * 64, ntl * 64, wl + LW_S1, DM, gu_row(ntl * 64, 0), W1_SCALE, scr, C.lane);
                    else cvt_tile(C.ap->in[I_WSG] + (size_t)l * DM * 512, 512, 512, kt * 64, ntl * 64, (bf16_t*)(wl + LW_S1), DM, gu_row(ntl * 64, 0), scr, C.lane); return; } r -= I_SG;
    if (r < I_SG) { const int kt = r / 8, ntl = r % 8; if (SH_FP8) cvt_tile_f8(C.ap->in[I_WSU] + (size_t)l * DM * 512, 512, 512, kt * 64, ntl * 64, wl + LW_S1, DM, gu_row(ntl * 64, 1), W1_SCALE, scr, C.lane);
                    else cvt_tile(C.ap->in[I_WSU] + (size_t)l * DM * 512, 512, 512, kt * 64, ntl * 64, (bf16_t*)(wl + LW_S1), DM, gu_row(ntl * 64, 1), scr, C.lane); return; } r -= I_SG;
    if (r < I_SD) { const int kt = r / 32, ntl = r % 32; if (SH_FP8) cvt_tile_f8<true>(C.ap->in[I_WSD] + (size_t)l * 512 * DM, DM, DM, kt * 64, ntl * 64, wl + LW_S2, 512, (ntl >> 2) * 256 + (ntl & 3) * 32, W2_SCALE, scr, C.lane);
                    else cvt_tile(C.ap->in[I_WSD] + (size_t)l * 512 * DM, DM, DM, kt * 64, ntl * 64, (bf16_t*)(wl + LW_S2), 512, ntl * 64, scr, C.lane); return; } r -= I_SD;
    cvt_tile(C.ap->in[I_WR] + (size_t)l * DM * 64, 64, 64, r * 64, 0, (bf16_t*)(wl + LW_R), DM, 0, scr, C.lane);
}
__device__ __forceinline__ void cvt_expert_item(const Ctx& C, int l, int r, LAS float* scr) {
    unsigned char* wl = C.ws + WS_W + (size_t)l * LW_BYTES;
    const int e = r / (2 * I_EG + I_ED); r -= e * (2 * I_EG + I_ED);
    const size_t eo = ((size_t)l * NE + e);
    if (r < I_EG) { const int kt = r / 8, ntl = r % 8; cvt_tile_f8(C.ap->in[I_WG] + eo * DM * 512, 512, 512, kt * 64, ntl * 64, wl + LW_1 + (size_t)e * 1024 * DM, DM, gu_row(ntl * 64, 0), W1_SCALE, scr, C.lane); return; } r -= I_EG;
    if (r < I_EG) { const int kt = r / 8, ntl = r % 8; cvt_tile_f8(C.ap->in[I_WU] + eo * DM * 512, 512, 512, kt * 64, ntl * 64, wl + LW_1 + (size_t)e * 1024 * DM, DM, gu_row(ntl * 64, 1), W1_SCALE, scr, C.lane); return; } r -= I_EG;
    { const int kt = r / 32, ntl = r % 32; cvt_tile_f8<true>(C.ap->in[I_WD] + eo * 512 * DM, DM, DM, kt * 64, ntl * 64, wl + LW_2 + (size_t)e * DM * 512, 512, (ntl >> 2) * 256 + (ntl & 3) * 32, W2_SCALE, scr, C.lane); }
}
__device__ __forceinline__ void phase_convert(const Ctx& C) {
    LAS float* scr = (LAS float*)(C.ldsl + C.wave * 16640);
    for (int it = C.gw; it < NL * I_SMALL; it += C.NGW) { const int l = it / I_SMALL; cvt_small_item(C, l, it - l * I_SMALL, scr); }
}
constexpr int CW_Q = 16384;
__device__ __forceinline__ void cvt_fill(const Ctx& C, unsigned target_arrivals) {
    unsigned long long* q0 = (unsigned long long*)((unsigned*)(C.ws + WS_CTL) + CW_Q); unsigned long long* q1 = q0 + 32;
    LAS int* wrd = (LAS int*)(C.ldsl + LDS_MISC + 64);
    LAS float* scr = (LAS float*)(C.ldsl + C.wave * 16640);
    __syncthreads();
    if (C.tid == 0) (void)__hip_atomic_fetch_add(q0, 1ull << 32, __ATOMIC_RELAXED, __HIP_MEMORY_SCOPE_AGENT);
    for (;;) {
        if (C.tid == 0) {
            const unsigned long long old = __hip_atomic_fetch_add(q0, 8ull, __ATOMIC_RELAXED, __HIP_MEMORY_SCOPE_AGENT);
            int idx = (int)(unsigned)(old & 0xffffffffull), lay = 0;
            if (idx >= I_EXP) { idx = (int)(unsigned)(__hip_atomic_fetch_add(q1, 8ull, __ATOMIC_RELAXED, __HIP_MEMORY_SCOPE_AGENT) & 0xffffffffull); lay = 1; }
            wrd[0] = idx; wrd[1] = lay; wrd[2] = ((unsigned)(old >> 32) >= target_arrivals) ? 1 : 0;
        }
        __syncthreads();
        const int idx = wrd[0], lay = wrd[1], last = wrd[2];
        __syncthreads();
#ifdef PROBE_EXTRA
        if (idx < I_EXP + (lay ? PROBE_EXTRA : 0)) cvt_expert_item(C, lay, (idx + C.wave) % I_EXP, scr);
#else
        if (idx < I_EXP) cvt_expert_item(C, lay, idx + C.wave, scr);
#endif
        else break;
        if (last) break;
    }
}
__device__ __forceinline__ void cvt_quota(const Ctx& C, int rounds) {
    unsigned long long* q0 = (unsigned long long*)((unsigned*)(C.ws + WS_CTL) + CW_Q); unsigned long long* q1 = q0 + 32;
    LAS int* wrd = (LAS int*)(C.ldsl + LDS_MISC + 64);
    LAS float* scr = (LAS float*)(C.ldsl + C.wave * 16640);
    __syncthreads();
#pragma unroll 1
    for (int r = 0; r < rounds; ++r) {
        if (C.tid == 0) {
            int idx = (int)(unsigned)(__hip_atomic_fetch_add(q0, 8ull, __ATOMIC_RELAXED, __HIP_MEMORY_SCOPE_AGENT) & 0xffffffffull), lay = 0;
            if (idx >= I_EXP) { idx = (int)(unsigned)(__hip_atomic_fetch_add(q1, 8ull, __ATOMIC_RELAXED, __HIP_MEMORY_SCOPE_AGENT) & 0xffffffffull); lay = 1; }
            wrd[0] = idx; wrd[1] = lay;
        }
        __syncthreads();
        const int idx = wrd[0], lay = wrd[1];
        __syncthreads();
        if (idx >= I_EXP) break;
        cvt_expert_item(C, lay, idx + C.wave, scr);
    }
    __syncthreads();
}
__device__ __forceinline__ void cvt_drain(const Ctx& C, int l) {
    unsigned long long* q = (unsigned long long*)((unsigned*)(C.ws + WS_CTL) + CW_Q) + 32 * l;
    LAS int* wrd = (LAS int*)(C.ldsl + LDS_MISC + 64);
    LAS float* scr = (LAS float*)(C.ldsl + C.wave * 16640);
    __syncthreads();
    for (;;) {
        if (C.tid == 0) wrd[0] = (int)(unsigned)(__hip_atomic_fetch_add(q, 8ull, __ATOMIC_RELAXED, __HIP_MEMORY_SCOPE_AGENT) & 0xffffffffull);
        __syncthreads();
        const int idx = wrd[0];
        __syncthreads();
#ifdef PROBE_EXTRA
        if (idx >= I_EXP + (l ? PROBE_EXTRA : 0)) break;
        cvt_expert_item(C, l, (idx + C.wave) % I_EXP, scr);
#else
        if (idx >= I_EXP) break;
        cvt_expert_item(C, l, idx + C.wave, scr);
#endif
    }
}

__device__ __forceinline__ void phase_adaln(const Ctx& C) {
    LAS float* sc = (LAS float*)C.ldsl;
    LAS float* red = (LAS float*)(C.ldsl + 65536);
    constexpr int NIT = NL * (6 * DM) / 128;
    if (C.bid >= NIT) return;
    for (int i = C.tid; i < NB * DM; i += NTHR) { const int b = i / DM, k = i % DM; const float v = C.ap->in[I_C][i]; sc[k * 8 + b] = v / (1.f + __expf(-v)); }
    __syncthreads();
    for (int it = C.bid; it < NIT; it += C.G) {
        const int l = it / (6 * DM / 128), n = (it % (6 * DM / 128)) * 128 + (C.tid & 127), kq = C.tid >> 7;
        const float* w = C.ap->in[I_WADA] + (size_t)l * DM * (6 * DM) + n;
        float a[8] = {0.f, 0.f, 0.f, 0.f, 0.f, 0.f, 0.f, 0.f};
        for (int k0 = kq * 512; k0 < kq * 512 + 512; k0 += 32) {
            float wv[32];
#pragma unroll
            for (int j = 0; j < 32; ++j) wv[j] = __builtin_nontemporal_load(w + (size_t)(k0 + j) * (6 * DM));
#pragma unroll
            for (int j = 0; j < 32; ++j) { const f32x4 s0 = *(const LAS f32x4*)(sc + (k0 + j) * 8), s1 = *(const LAS f32x4*)(sc + (k0 + j) * 8 + 4);
                a[0] += s0[0] * wv[j]; a[1] += s0[1] * wv[j]; a[2] += s0[2] * wv[j]; a[3] += s0[3] * wv[j];
                a[4] += s1[0] * wv[j]; a[5] += s1[1] * wv[j]; a[6] += s1[2] * wv[j]; a[7] += s1[3] * wv[j]; }
        }
#pragma unroll
        for (int b = 0; b < 8; ++b) red[(kq * 128 + (C.tid & 127)) * 8 + b] = a[b];
        __syncthreads();
        if (C.tid < 128) {
            const float bias = C.ap->in[I_BADA][(size_t)l * 6 * DM + n];
            float* mod = (float*)(C.ws + WS_MOD) + (size_t)l * NB * 6 * DM;
#pragma unroll
            for (int b = 0; b < 8; ++b) { const float s = ((red[(0 * 128 + C.tid) * 8 + b] + red[(1 * 128 + C.tid) * 8 + b]) + red[(2 * 128 + C.tid) * 8 + b]) + red[(3 * 128 + C.tid) * 8 + b];
                mod[(size_t)b * 6 * DM + n] = s + bias; }
        }
        __syncthreads();
    }
}

__device__ __forceinline__ void norm_mod_rows(const float* x, const float* g, const float* msh, const float* msc, unsigned char* h8, bf16_t* h, int row0, int nrows, int lane) {
    const int b = row0 / SEQ;
    f32x4 a[8], s[8];
#pragma unroll
    for (int j = 0; j < 8; ++j) { const int col = 4 * lane + 256 * j; const f32x4 gg = *(const f32x4*)(g + col), sc = *(const f32x4*)(msc + (size_t)b * 6 * DM + col);
        a[j] = gg * (sc + 1.f); s[j] = *(const f32x4*)(msh + (size_t)b * 6 * DM + col); }
    for (int r = 0; r < nrows; ++r) {
        const float* xr = x + (size_t)(row0 + r) * DM;
        f32x4 v[8]; float ss = 0.f;
#pragma unroll
        for (int j = 0; j < 8; ++j) { v[j] = *(const f32x4*)(xr + 4 * lane + 256 * j); ss += (v[j][0] * v[j][0] + v[j][1] * v[j][1]) + (v[j][2] * v[j][2] + v[j][3] * v[j][3]); }
        const float rstd = rsqrtf(wave_sum(ss) * (1.f / DM) + EPS);
        unsigned char* hr = h8 + (size_t)(row0 + r) * DM;
#pragma unroll
        for (int j = 0; j < 8; ++j) { const f32x4 y = v[j] * rstd * a[j] + s[j];
            if (WIN_FP8 != 0) *(unsigned*)(hr + 4 * lane + 256 * j) = pk4_fp8(y[0], y[1], y[2], y[3]);
            if (WIN_FP8 != 1) { u32x2 w; w.x = cvtpk(y[0], y[1]); w.y = cvtpk(y[2], y[3]); *(u32x2*)(h + (size_t)(row0 + r) * DM + 4 * lane + 256 * j) = w; } }
    }
}

__device__ __forceinline__ void rope8(u32x4& A, u32x4& B, const LAS float* tb) {
    const f32x4 t0 = *(const LAS f32x4*)tb, t1 = *(const LAS f32x4*)(tb + 4), t2 = *(const LAS f32x4*)(tb + 8), t3 = *(const LAS f32x4*)(tb + 12);
#define R8W(w, ca, sa, cb, sb) do { const float x1a = bflo(A.w), x1b = bfhi(A.w), x2a = bflo(B.w), x2b = bfhi(B.w); \
        A.w = cvtpk(x1a * (ca) - x2a * (sa), x1b * (cb) - x2b * (sb)); B.w = cvtpk(x2a * (ca) + x1a * (sa), x2b * (cb) + x1b * (sb)); } while (0)
    R8W(x, t0[0], t0[1], t0[2], t0[3]); R8W(y, t1[0], t1[1], t1[2], t1[3]); R8W(z, t2[0], t2[1], t2[2], t2[3]); R8W(w, t3[0], t3[1], t3[2], t3[3]);
#undef R8W
}
__device__ __forceinline__ void phase_postproj(const Ctx& C, int l) {
    bf16_t* proj = (bf16_t*)(C.ws + WS_PROJ); float* cs = (float*)(C.ws + WS_CS);
    const float* gcq = C.ap->in[I_GCQ] + (size_t)l * 512; const float* gckv = C.ap->in[I_GCKV] + (size_t)l * 256;
    const int* pos = (const int*)C.ap->in[I_POS];
    const int lane = C.lane;
    LAS float* tab64 = (LAS float*)(C.ldsl + C.wave * 1024); LAS float* tab128 = tab64 + 64;
    const float inv64 = exp2f(-(float)(lane & 31) * (2.f / 64.f) * 13.287712379549449f);
    const float inv128 = exp2f(-(float)lane * (2.f / 128.f) * 13.287712379549449f);
    const int o1 = O_IXQ + (lane >> 2) * 64 + (lane & 3) * 8, t1 = (lane & 3) * 16;
    int o2, d2, t2;
    if (lane < 32) { o2 = O_DSQ + (lane >> 3) * 128 + (lane & 7) * 8; d2 = 64; t2 = 64 + (lane & 7) * 16; }
    else if (lane < 40) { o2 = O_DSK + (lane - 32) * 8; d2 = 64; t2 = 64 + (lane - 32) * 16; }
    else if (lane < 44) { o2 = O_KR + (lane - 40) * 8; d2 = 32; t2 = (lane - 40) * 16; }
    else { o2 = O_IXK + ((lane - 44) & 3) * 8; d2 = 32; t2 = ((lane - 44) & 3) * 16; }
    const bool g2 = lane < 48;
    u32x4 nq, na1, nb1, na2, nb2; u32x2 nk; int npos;
#define PP_LOAD(tt) do { const bf16_t* p_ = proj + (size_t)(tt) * NPROJ; nq = *(const u32x4*)(p_ + O_CQ + lane * 8); nk = *(const u32x2*)(p_ + O_CKV + lane * 4); \
        na1 = *(const u32x4*)(p_ + o1); nb1 = *(const u32x4*)(p_ + o1 + 32); na2 = *(const u32x4*)(p_ + o2); nb2 = *(const u32x4*)(p_ + o2 + d2); npos = pos[tt]; } while (0)
    if (C.gw < T) PP_LOAD(C.gw);
    for (int t = C.gw; t < T; t += C.NGW) {
        bf16_t* p = proj + (size_t)t * NPROJ;
        u32x4 wq = nq; u32x2 wk = nk; u32x4 a1 = na1, b1 = nb1, a2 = na2, b2 = nb2;
        const float ps = (float)npos;
        { const int tn = (t + C.NGW < T) ? t + C.NGW : t; PP_LOAD(tn); }
        { const float t64 = ps * inv64 * 0.15915494309189535f, t128 = ps * inv128 * 0.15915494309189535f;
          const float f64 = t64 - floorf(t64), f128 = t128 - floorf(t128);
          const float s64 = __builtin_amdgcn_sinf(f64), c64 = __builtin_amdgcn_cosf(f64), s128 = __builtin_amdgcn_sinf(f128), c128 = __builtin_amdgcn_cosf(f128);
          if (lane < 32) { *(LAS f32x2*)(tab64 + 2 * lane) = (f32x2){c64, s64}; *(f32x2*)(cs + (size_t)t * 64 + 2 * lane) = (f32x2){c64, s64}; }
          *(LAS f32x2*)(tab128 + 2 * lane) = (f32x2){c128, s128}; }
        { float f[8] = {bflo(wq.x), bfhi(wq.x), bflo(wq.y), bfhi(wq.y), bflo(wq.z), bfhi(wq.z), bflo(wq.w), bfhi(wq.w)};
          float ss = 0.f;
#pragma unroll
          for (int j = 0; j < 8; ++j) ss += f[j] * f[j];
          const float r = rsqrtf(wave_sum(ss) * (1.f / 512.f) + EPS);
          const f32x4 g0 = *(const f32x4*)(gcq + lane * 8), g1 = *(const f32x4*)(gcq + lane * 8 + 4);
          wq.x = cvtpk(f[0] * r * g0[0], f[1] * r * g0[1]); wq.y = cvtpk(f[2] * r * g0[2], f[3] * r * g0[3]); wq.z = cvtpk(f[4] * r * g1[0], f[5] * r * g1[1]); wq.w = cvtpk(f[6] * r * g1[2], f[7] * r * g1[3]);
          if (!UQ_FP8) *(u32x4*)(p + O_CQ + lane * 8) = wq;
          if (UQ_FP8) { u32x2 w8; w8.x = pk4_fp8(f[0] * r * g0[0], f[1] * r * g0[1], f[2] * r * g0[2], f[3] * r * g0[3]); w8.y = pk4_fp8(f[4] * r * g1[0], f[5] * r * g1[1], f[6] * r * g1[2], f[7] * r * g1[3]);
                        *(u32x2*)(C.ws + WS_CQ8 + (size_t)t * 512 + lane * 8) = w8; } }
        { float f[4] = {bflo(wk.x), bfhi(wk.x), bflo(wk.y), bfhi(wk.y)};
          const float ss = (f[0] * f[0] + f[1] * f[1]) + (f[2] * f[2] + f[3] * f[3]);
          const float r = rsqrtf(wave_sum(ss) * (1.f / 256.f) + EPS);
          const f32x4 g0 = *(const f32x4*)(gckv + lane * 4);
          wk.x = cvtpk(f[0] * r * g0[0], f[1] * r * g0[1]); wk.y = cvtpk(f[2] * r * g0[2], f[3] * r * g0[3]);
          if (!UKV_FP8) *(u32x2*)(p + O_CKV + lane * 4) = wk;
          if (UKV_FP8) *(unsigned*)(C.ws + WS_CKV8 + (size_t)t * 256 + lane * 4) = pk4_fp8(f[0] * r * g0[0], f[1] * r * g0[1], f[2] * r * g0[2], f[3] * r * g0[3]); }
        LDS_WAIT();
        rope8(a1, b1, tab64 + t1); rope8(a2, b2, tab64 + t2);
        *(u32x4*)(p + o1) = a1; *(u32x4*)(p + o1 + 32) = b1;
        if (g2) { *(u32x4*)(p + o2) = a2; *(u32x4*)(p + o2 + d2) = b2; }
        LDS_WAIT();
    }
}
#undef PP_LOAD

#define KSWZ(row, colB) ((row) * 256 + ((colB) ^ (((row) & 7) << 4)))
constexpr int SHM_V = 64 * 128 * 2, SHM_K = 64 * 128 * 2, SHM_KR = 64 * 64 * 2;
constexpr int ATT_V = 0, ATT_K = SHM_V, ATT_KR = SHM_V + SHM_K, ATT_WS = ATT_KR + SHM_KR;
__device__ __forceinline__ int v_st(int k, int c) { const int kk = (k & ~0xC) | ((k & 4) << 1) | ((k & 8) >> 1); return ((kk >> 3) * 4 + (c >> 5)) * 512 + ((kk & 7) * 32 + (c & 31)) * 2; }
__device__ __forceinline__ int v_rd_base(int lane) { return ((lane & 3) << 3) | (((lane >> 2) & 3) << 6) | (((lane >> 4) & 1) << 5) | (((lane >> 5) & 1) << 8); }
constexpr int v_rd_off(int d0, int ks, int half) { return d0 * 512 + ks * 4096 + half * 2048; }
__device__ __forceinline__ int crow(int r, int hi) { return (r & 3) + 8 * (r >> 2) + 4 * hi; }
__device__ __forceinline__ float xchg32(float x, int hi) {
    auto rr = __builtin_amdgcn_permlane32_swap(__float_as_uint(x), __float_as_uint(x), false, false);
    return __uint_as_float(hi ? rr[0] : rr[1]);
}
__device__ __forceinline__ void mask_causal(f32x16& p0, f32x16& p1, int dq) {
    const float NEG = -__builtin_inff();
#pragma unroll
    for (int r = 0; r < 16; ++r) {
        const int c = (r & 3) + 8 * (r >> 2);
        if (dq - c < 0) p0[r] = NEG;
        if (dq - c - 32 < 0) p1[r] = NEG;
    }
}
__device__ __forceinline__ void mask_bits(f32x16& p0, f32x16& p1, unsigned lo, unsigned hw, int hi) {
    const float NEG = -__builtin_inff();
    lo >>= 4 * hi; hw >>= 4 * hi;
#pragma unroll
    for (int r = 0; r < 16; ++r) {
        const int c = (r & 3) + 8 * (r >> 2);
        if (((lo >> c) & 1u) == 0u) p0[r] = NEG;
        if (((hw >> c) & 1u) == 0u) p1[r] = NEG;
    }
}
constexpr float ATT_THR = 8.f;
__device__ __forceinline__ void partialSM(f32x16& p0, f32x16& p1, float& m_reg, float& mn, float& alpha, const float scale) {
    float pmax = p0[0];
#pragma unroll
    for (int r = 1; r < 16; ++r) pmax = fmaxf(pmax, p0[r]);
#pragma unroll
    for (int r = 0; r < 16; ++r) pmax = fmaxf(pmax, p1[r]);
    { auto rr = __builtin_amdgcn_permlane32_swap(__float_as_uint(pmax), __float_as_uint(pmax), false, false);
      pmax = fmaxf(__uint_as_float(rr[0]), __uint_as_float(rr[1])); }
    const float C2 = 1.4426950408889634f * scale;
    if (__builtin_expect(__all((pmax - m_reg) * scale <= ATT_THR), 1)) { mn = m_reg; alpha = 1.f; }
    else { mn = fmaxf(m_reg, pmax); alpha = __builtin_amdgcn_exp2f((m_reg - mn) * C2); m_reg = mn; }
    const float mnL = -mn * C2;
#pragma unroll
    for (int r = 0; r < 16; ++r) p0[r] = fmaf(p0[r], C2, mnL);
#pragma unroll
    for (int r = 0; r < 16; ++r) p1[r] = fmaf(p1[r], C2, mnL);
#pragma unroll
    for (int r = 0; r < 16; ++r) p0[r] = __builtin_amdgcn_exp2f(p0[r]);
}
#define PK4(P, B_, OUT) do { unsigned a0 = cvtpk(P[B_+0], P[B_+1]), a1 = cvtpk(P[B_+2], P[B_+3]);                          \
        unsigned b0 = cvtpk(P[B_+4], P[B_+5]), b1 = cvtpk(P[B_+6], P[B_+7]);                                             \
        auto r0 = __builtin_amdgcn_permlane32_swap(a0, b0, false, false); auto r1 = __builtin_amdgcn_permlane32_swap(a1, b1, false, false); \
        u32x4 w = {r0[0], r1[0], r0[1], r1[1]}; OUT = *reinterpret_cast<bf16x8*>(&w); } while (0)
__device__ __forceinline__ void packP(const f32x16& p0, const f32x16& p1, bf16x8& pa0, bf16x8& pa1, bf16x8& pa2, bf16x8& pa3) {
    PK4(p0, 0, pa0); PK4(p0, 8, pa1); PK4(p1, 0, pa2); PK4(p1, 8, pa3);
}
__device__ __forceinline__ void finishSM(f32x16& p0, f32x16& p1, float alpha, float& l_reg, bf16x8& pa0, bf16x8& pa1, bf16x8& pa2, bf16x8& pa3) {
#pragma unroll
    for (int r = 0; r < 16; ++r) p1[r] = __builtin_amdgcn_exp2f(p1[r]);
    float ps = 0;
#pragma unroll
    for (int r = 0; r < 16; ++r) ps += p0[r];
#pragma unroll
    for (int r = 0; r < 16; ++r) ps += p1[r];
    { auto rr = __builtin_amdgcn_permlane32_swap(__float_as_uint(ps), __float_as_uint(ps), false, false);
      ps = __uint_as_float(rr[0]) + __uint_as_float(rr[1]); }
    l_reg = l_reg * alpha + ps;
    packP(p0, p1, pa0, pa1, pa2, pa3);
}
template <int NKD>
__device__ __forceinline__ void qkt(f32x16& p0, f32x16& p1, const LAS unsigned char* K_lds, const LAS unsigned char* KR_lds, int r32, int hi, const bf16x8* qr) {
    p0 = f32x16{}; p1 = f32x16{};
    const LAS unsigned char* kb[4];
#pragma unroll
    for (int dd = 0; dd < 4; ++dd) kb[dd] = K_lds + KSWZ(r32, (dd * 16 + hi * 8) * 2);
#pragma unroll
    for (int d0 = 0; d0 < 8; ++d0) { const LAS unsigned char* a = kb[d0 & 3] + (d0 >> 2) * 128;
        bf16x8 b0 = *(const LAS bf16x8*)(a);
        bf16x8 b1 = *(const LAS bf16x8*)(a + 32 * 256);
        p0 = __builtin_amdgcn_mfma_f32_32x32x16_bf16(b0, qr[d0], p0, 0, 0, 0);
        p1 = __builtin_amdgcn_mfma_f32_32x32x16_bf16(b1, qr[d0], p1, 0, 0, 0); }
    if constexpr (NKD == 12) {
#pragma unroll
        for (int d0 = 0; d0 < 4; ++d0) { const LAS unsigned char* a = KR_lds + r32 * 128 + (((d0 * 16 + hi * 8) * 2) ^ ((r32 & 7) << 4));
            bf16x8 b0 = *(const LAS bf16x8*)(a);
            bf16x8 b1 = *(const LAS bf16x8*)(a + 32 * 128);
            p0 = __builtin_amdgcn_mfma_f32_32x32x16_bf16(b0, qr[8 + d0], p0, 0, 0, 0);
            p1 = __builtin_amdgcn_mfma_f32_32x32x16_bf16(b1, qr[8 + d0], p1, 0, 0, 0); }
    }
}
__device__ __forceinline__ void pv_tile(f32x16* o, int vb0, bf16x8 pa0, bf16x8 pa1, bf16x8 pa2, bf16x8 pa3) {
#define TRRD(dst, off) asm volatile("ds_read_b64_tr_b16 %0, %1 offset:%2" : "=&v"(dst) : "v"(vb0), "i"(off) : "memory")
#define PV_D0(d0) do { s16x4 l0, l1, l2, l3, h0, h1, h2, h3; constexpr int b_ = v_rd_off(d0, 0, 0); \
        TRRD(l0, b_); TRRD(h0, b_ + 2048); TRRD(l1, b_ + 4096); TRRD(h1, b_ + 6144); TRRD(l2, b_ + 8192); TRRD(h2, b_ + 10240); TRRD(l3, b_ + 12288); TRRD(h3, b_ + 14336); \
        asm volatile("s_waitcnt lgkmcnt(0)" ::: "memory"); SBAR();   \
        o[d0] = __builtin_amdgcn_mfma_f32_32x32x16_bf16(pa0, (bf16x8){l0[0], l0[1], l0[2], l0[3], h0[0], h0[1], h0[2], h0[3]}, o[d0], 0, 0, 0);   \
        o[d0] = __builtin_amdgcn_mfma_f32_32x32x16_bf16(pa1, (bf16x8){l1[0], l1[1], l1[2], l1[3], h1[0], h1[1], h1[2], h1[3]}, o[d0], 0, 0, 0);   \
        o[d0] = __builtin_amdgcn_mfma_f32_32x32x16_bf16(pa2, (bf16x8){l2[0], l2[1], l2[2], l2[3], h2[0], h2[1], h2[2], h2[3]}, o[d0], 0, 0, 0);   \
        o[d0] = __builtin_amdgcn_mfma_f32_32x32x16_bf16(pa3, (bf16x8){l3[0], l3[1], l3[2], l3[3], h3[0], h3[1], h3[2], h3[3]}, o[d0], 0, 0, 0); } while (0)
    PV_D0(0); PV_D0(1); PV_D0(2); PV_D0(3);
#undef PV_D0
#undef TRRD
}

struct AttnWave {
    const bf16_t* Q; int ldq;
    const float* cs;
    const bf16_t* K; int ldk;
    const bf16_t* KR; int ldkr;
    const bf16_t* V; int ldv;
    const unsigned long long* mw;
    bf16_t* O; int ldo;
    const float* gout;
    int qlo;
    int nt_w;
};
__device__ __forceinline__ void attn_store(const f32x16* o, LAS float* ws, const AttnWave& A, int r32, int hi, bool use_l, float l_reg) {
    LAS float* li_l = ws;
    asm volatile("" : "+v"(r32), "+v"(hi));
    if (use_l) { if (hi == 0) li_l[r32] = l_reg; LDS_WAIT(); }
    float gv[4];
#pragma unroll
    for (int d0 = 0; d0 < 4; ++d0) gv[d0] = A.gout[d0 * 32 + r32];
#pragma unroll
    for (int r = 0; r < 16; ++r) {
        const int orow = crow(r, hi);
        const float il = use_l ? __builtin_amdgcn_rcpf(li_l[orow]) : 1.f;
        float v[4]; float ss = 0.f;
#pragma unroll
        for (int d0 = 0; d0 < 4; ++d0) { v[d0] = o[d0][r] * il; ss += v[d0] * v[d0]; }
        ss += __shfl_xor(ss, 1); ss += __shfl_xor(ss, 2); ss += __shfl_xor(ss, 4); ss += __shfl_xor(ss, 8); ss += __shfl_xor(ss, 16);
        const float rs = rsqrtf(ss * (1.f / 128.f) + EPS);
#pragma unroll
        for (int d0 = 0; d0 < 4; ++d0) { const float y = v[d0] * rs * gv[d0];
            if (WO_FP8) { const float y1 = __shfl_xor(y, 1), y2 = __shfl_xor(y, 2), y3 = __shfl_xor(y, 3);
                if ((r32 & 3) == 0) *(unsigned*)((unsigned char*)A.O + (size_t)orow * A.ldo + d0 * 32 + r32) = pk4_fp8(y, y1, y2, y3); }
            else { const float yn = __shfl_xor(y, 1);
                if ((r32 & 1) == 0) *(unsigned*)(A.O + (size_t)orow * A.ldo + d0 * 32 + r32) = cvtpk(y, yn); } }
    }
}
constexpr int ATT_BUF = SHM_V + SHM_K + SHM_KR;
constexpr int ATT_WS2 = 2 * ATT_BUF;
template <bool HASKR>
struct TileDma {
    unsigned ko[2], vo[2], kro;
    __device__ __forceinline__ void init(const AttnWave& A, int wid, int lane) {
#pragma unroll
        for (int j = 0; j < 2; ++j) {
            const int p = (wid * 2 + j) * 64 + lane;
            { const int row = p >> 4, ch = (p & 15) ^ (row & 7); ko[j] = (unsigned)(row * A.ldk + ch * 8) * 2u; }
            { const int sub = p >> 5, q = p & 31, kk = (sub >> 2) * 8 + (q >> 2), c = (sub & 3) * 32 + (q & 3) * 8;
              const int k = (kk & ~0xC) | ((kk & 4) << 1) | ((kk & 8) >> 1); vo[j] = (unsigned)(k * A.ldv + c) * 2u; }
        }
        if constexpr (HASKR) { const int p = wid * 64 + lane, row = p >> 3, ch = (p & 7) ^ (row & 7); kro = (unsigned)(row * A.ldkr + ch * 8) * 2u; } else kro = 0u;
    }
    __device__ __forceinline__ void issue_at(LAS unsigned char* ldsl, int boff, const AttnWave& A, int kb, int wid) const {
        const char* kbase = (const char*)A.K + (size_t)kb * A.ldk * 2; const char* vbase = (const char*)A.V + (size_t)kb * A.ldv * 2;
#pragma unroll
        for (int j = 0; j < 2; ++j) {
            __builtin_amdgcn_global_load_lds((const unsigned*)(kbase + ko[j]), (LAS unsigned*)(ldsl + boff + ATT_K + (wid * 2 + j) * 1024), 16, 0, 0);
            __builtin_amdgcn_global_load_lds((const unsigned*)(vbase + vo[j]), (LAS unsigned*)(ldsl + boff + ATT_V + (wid * 2 + j) * 1024), 16, 0, 0);
        }
        if constexpr (HASKR) { const char* rbase = (const char*)A.KR + (size_t)kb * A.ldkr * 2;
            __builtin_amdgcn_global_load_lds((const unsigned*)(rbase + kro), (LAS unsigned*)(ldsl + boff + ATT_KR + wid * 1024), 16, 0, 0); }
    }
};

template <int MODE>
__device__ __forceinline__ void attn_softmax_block(LAS unsigned char* ldsl, const int tid, const AttnWave& A, int nt_wg, float scale) {
    constexpr bool MLA = (MODE == 0); constexpr int NKD = MLA ? 12 : 8;
    const int wid = __builtin_amdgcn_readfirstlane(tid >> 6), lane = tid & 63, r32 = lane & 31, hi = lane >> 5;
    LAS float* ws = (LAS float*)(ldsl + 3 * ATT_BUF) + wid * 64; LAS float* al_l = ws + 32;
    bf16x8 qr[NKD];
#pragma unroll
    for (int d0 = 0; d0 < NKD; ++d0) qr[d0] = *(const bf16x8*)(A.Q + (size_t)r32 * A.ldq + d0 * 16 + hi * 8);
    if constexpr (MLA) {
#pragma unroll
        for (int dd = 0; dd < 2; ++dd) {
            bf16x8 x1 = qr[8 + dd], x2 = qr[10 + dd];
#pragma unroll
            for (int j = 0; j < 8; ++j) { const int i = dd * 16 + hi * 8 + j; const f32x2 c = *(const f32x2*)(A.cs + (size_t)r32 * 64 + 2 * i);
                const float a = bf2f((unsigned short)x1[j]), b = bf2f((unsigned short)x2[j]);
                x1[j] = (short)f2bf(a * c[0] - b * c[1]); x2[j] = (short)f2bf(b * c[0] + a * c[1]); }
            qr[8 + dd] = x1; qr[10 + dd] = x2;
        }
    }
    float m_reg = -1e30f, l_reg = 0.f; f32x16 o[4] = {};
    const int vbase = (int)(unsigned)(uintptr_t)(ldsl + ATT_V) + v_rd_base(lane);
    const int qm = A.qlo + r32 - 4 * hi;
    TileDma<MLA> dma; dma.init(A, wid, lane);
    constexpr int TB = MLA ? ATT_BUF : (SHM_V + SHM_K), NP = MLA ? 5 : 4;
    LAS unsigned long long* maskl = (LAS unsigned long long*)(ldsl + 3 * (SHM_V + SHM_K)) + (wid >> 2) * 1024;
    if constexpr (MODE == 2) {
        const int tg = (wid & 3) * 64 + lane;
#pragma unroll
        for (int j = 0; j < 4; ++j) maskl[tg + 256 * j] = A.mw[tg + 256 * j];
        __syncthreads();
    }
    dma.issue_at(ldsl, 0, A, 0, wid); if (nt_wg > 1) dma.issue_at(ldsl, TB, A, 64, wid);
    if (wid < 4) __builtin_amdgcn_s_setprio(2); else __builtin_amdgcn_s_setprio(0);
    int bcur = 0;
    for (int t = 0; t < nt_wg; ++t) {
        const int kb = t * 64;
        if (t + 1 < nt_wg) { if constexpr (MLA) asm volatile("s_waitcnt vmcnt(5)" ::: "memory"); else asm volatile("s_waitcnt vmcnt(4)" ::: "memory"); } else VM_WAIT();
        asm volatile("s_waitcnt lgkmcnt(0)" ::: "memory"); __builtin_amdgcn_s_barrier(); asm volatile("" ::: "memory");
        const int bfree = (bcur == 0) ? 2 : bcur - 1;
        if (t + 2 < nt_wg) dma.issue_at(ldsl, bfree * TB, A, kb + 128, wid);
        if (t < A.nt_w) {
            f32x16 p0, p1; float mn, al; bf16x8 pa0, pa1, pa2, pa3;
            const int vb0 = vbase + bcur * TB;
            qkt<NKD>(p0, p1, ldsl + bcur * TB + ATT_K, ldsl + bcur * TB + ATT_KR, r32, hi, qr);
            if constexpr (MODE == 2) { const unsigned long long mw_cur = maskl[r32 * 32 + t]; mask_bits(p0, p1, (unsigned)mw_cur, (unsigned)(mw_cur >> 32), hi); }
            else { if (kb + 63 > A.qlo) mask_causal(p0, p1, qm - kb); }
            partialSM(p0, p1, m_reg, mn, al, scale);
            if (__any(al < 1.f)) { if (hi == 0) al_l[r32] = al; LDS_WAIT();
#pragma unroll
                for (int d = 0; d < 4; ++d)
#pragma unroll
                    for (int r = 0; r < 16; ++r) o[d][r] *= al_l[crow(r, hi)]; }
            finishSM(p0, p1, al, l_reg, pa0, pa1, pa2, pa3);
            pv_tile(o, vb0, pa0, pa1, pa2, pa3);
        }
        bcur = (bcur == 2) ? 0 : bcur + 1;
    }
    __builtin_amdgcn_s_setprio(0);
    attn_store(o, ws, A, r32, hi, true, l_reg);
    __syncthreads();
}

constexpr int DSA_TB = 32768;
__device__ __forceinline__ void attn_dsa_block(LAS unsigned char* ldsl, const int tid, const AttnWave& A, int nt, float scale) {
    const int wid = __builtin_amdgcn_readfirstlane(tid >> 6), lane = tid & 63, r32 = lane & 31, hi = lane >> 5, grp = wid >> 2, head = wid & 3;
    LAS float* ws = (LAS float*)(ldsl + 4 * DSA_TB + 8192) + wid * 64; LAS float* al_l = ws + 32;
    LAS unsigned long long* maskl = (LAS unsigned long long*)(ldsl + 4 * DSA_TB);
    { const int tg = wid * 64 + lane; maskl[tg] = A.mw[tg]; maskl[tg + 512] = A.mw[tg + 512]; }
    bf16x8 qr[8];
#pragma unroll
    for (int d0 = 0; d0 < 8; ++d0) qr[d0] = *(const bf16x8*)(A.Q + (size_t)r32 * A.ldq + d0 * 16 + hi * 8);
    float m_reg = -1e30f, l_reg = 0.f; f32x16 o[4] = {};
    const int vbase = (int)(unsigned)(uintptr_t)(ldsl + ATT_V) + v_rd_base(lane);
    TileDma<false> dma; dma.init(A, wid, lane);
    const int nticks = (nt + 1) >> 1;
    dma.issue_at(ldsl, 0, A, 0, wid); if (nt > 1) dma.issue_at(ldsl, DSA_TB, A, 64, wid);
    for (int s = 0; s < nticks; ++s) {
        const int pair = (s & 1) * 2 * DSA_TB;
        VM_WAIT(); __syncthreads();
        if (s + 1 < nticks) { const int np = pair ^ (2 * DSA_TB); dma.issue_at(ldsl, np, A, (2 * s + 2) * 64, wid); if (2 * s + 3 < nt) dma.issue_at(ldsl, np + DSA_TB, A, (2 * s + 3) * 64, wid); }
        const int t = 2 * s + grp;
        if (t < nt) {
            f32x16 p0, p1; float mn, al; bf16x8 pa0, pa1, pa2, pa3;
            const int boff = pair + grp * DSA_TB;
            qkt<8>(p0, p1, ldsl + boff + ATT_K, ldsl + boff + ATT_K, r32, hi, qr);
            { const unsigned long long w = maskl[r32 * 32 + t]; mask_bits(p0, p1, (unsigned)w, (unsigned)(w >> 32), hi); }
            partialSM(p0, p1, m_reg, mn, al, scale);
            if (__any(al < 1.f)) { if (hi == 0) al_l[r32] = al; LDS_WAIT();
#pragma unroll
                for (int d = 0; d < 4; ++d)
#pragma unroll
                    for (int r = 0; r < 16; ++r) o[d][r] *= al_l[crow(r, hi)]; }
            finishSM(p0, p1, al, l_reg, pa0, pa1, pa2, pa3);
            pv_tile(o, vbase + boff, pa0, pa1, pa2, pa3);
        }
    }
    __syncthreads();
    LAS float* xo = (LAS float*)ldsl + head * 4096;
    LAS float* xm = (LAS float*)(ldsl + 65536) + head * 128;
    if (grp == 1) {
#pragma unroll
        for (int d = 0; d < 4; ++d)
#pragma unroll
            for (int r = 0; r < 16; ++r) xo[(d * 16 + r) * 64 + lane] = o[d][r];
        xm[lane] = m_reg; xm[64 + lane] = l_reg;
    }
    __syncthreads();
    if (grp == 0) {
        const float m1 = xm[lane], l1 = xm[64 + lane];
        const float C2 = 1.4426950408889634f * scale;
        const float mm = fmaxf(m_reg, m1), a0 = __builtin_amdgcn_exp2f((m_reg - mm) * C2), a1 = __builtin_amdgcn_exp2f((m1 - mm) * C2);
        l_reg = l_reg * a0 + l1 * a1;
        if (hi == 0) al_l[r32] = a0; LDS_WAIT();
#pragma unroll
        for (int d = 0; d < 4; ++d)
#pragma unroll
            for (int r = 0; r < 16; ++r) o[d][r] *= al_l[crow(r, hi)];
        LDS_WAIT();
        if (hi == 0) al_l[r32] = a1; LDS_WAIT();
#pragma unroll
        for (int d = 0; d < 4; ++d)
#pragma unroll
            for (int r = 0; r < 16; ++r) o[d][r] = fmaf(xo[(d * 16 + r) * 64 + lane], al_l[crow(r, hi)], o[d][r]);
        attn_store(o, ws, A, r32, hi, true, l_reg);
    }
    __syncthreads();
}

__device__ __forceinline__ void attn_sb_block(LAS unsigned char* ldsl, const int tid, const AttnWave& A, int nt_wg, float scale) {
    const int wid = __builtin_amdgcn_readfirstlane(tid >> 6), lane = tid & 63, r32 = lane & 31, hi = lane >> 5;
    LAS float* ws = (LAS float*)(ldsl + 3 * ATT_BUF) + wid * 64;
    bf16x8 qr[8];
#pragma unroll
    for (int d0 = 0; d0 < 8; ++d0) qr[d0] = *(const bf16x8*)(A.Q + (size_t)r32 * A.ldq + d0 * 16 + hi * 8);
    float carry = 0.f; f32x16 o[4] = {};
    const int vbase = (int)(unsigned)(uintptr_t)(ldsl + ATT_V) + v_rd_base(lane);
    const int qm = A.qlo + r32 - 4 * hi;
    LAS int* wflag = (LAS int*)(ldsl + 3 * ATT_BUF + 2048);
    bool wdone = false;
    if (lane == 0) wflag[wid] = 0;
    TileDma<false> dma; dma.init(A, wid, lane);
    constexpr int TB = SHM_V + SHM_K;
    dma.issue_at(ldsl, 0, A, (nt_wg - 1) * 64, wid); if (nt_wg > 1) dma.issue_at(ldsl, TB, A, (nt_wg - 2) * 64, wid);
    int bcur = 0;
    for (int t = nt_wg - 1; t >= 0; --t, bcur = (bcur == 2) ? 0 : bcur + 1) {
        const int kb = t * 64;
        if (t > 0) asm volatile("s_waitcnt vmcnt(4)" ::: "memory"); else VM_WAIT();
        asm volatile("s_waitcnt lgkmcnt(0)" ::: "memory"); __builtin_amdgcn_s_barrier(); asm volatile("" ::: "memory");
        { const u32x4 f0 = *(const LAS u32x4*)wflag, f1 = *(const LAS u32x4*)(wflag + 4);
          if ((f0.x & f0.y & f0.z & f0.w & f1.x & f1.y & f1.z & f1.w) != 0u) break; }
        { const int bfree = (bcur == 0) ? 2 : bcur - 1; if (t >= 2) dma.issue_at(ldsl, bfree * TB, A, kb - 128, wid); }
        if (t < A.nt_w && !wdone) {
            f32x16 p0, p1, L0, L1; bf16x8 pa0, pa1, pa2, pa3;
            const int vb0 = vbase + bcur * TB;
            qkt<8>(p0, p1, ldsl + bcur * TB + ATT_K, ldsl + bcur * TB + ATT_K, r32, hi, qr);
            const int dq = qm - kb;
#pragma unroll
            for (int r = 0; r < 16; ++r) { const int c = (r & 3) + 8 * (r >> 2);
                { const float z = p0[r] * scale; const float sp = __builtin_amdgcn_logf(1.f + __builtin_amdgcn_exp2f(-fabsf(z) * 1.4426950408889634f)) * 0.6931471805599453f;
                  const float ls = fminf(z, 0.f) - sp; p0[r] = ls; L0[r] = (dq - c > 0) ? (ls - z) : 0.f; }
                { const float z = p1[r] * scale; const float sp = __builtin_amdgcn_logf(1.f + __builtin_amdgcn_exp2f(-fabsf(z) * 1.4426950408889634f)) * 0.6931471805599453f;
                  const float ls = fminf(z, 0.f) - sp; p1[r] = ls; L1[r] = (dq - c - 32 > 0) ? (ls - z) : 0.f; } }
            float gs[8], pg[8], after[8];
#pragma unroll
            for (int g = 0; g < 4; ++g) { gs[g] = (L0[4 * g] + L0[4 * g + 1]) + (L0[4 * g + 2] + L0[4 * g + 3]); gs[4 + g] = (L1[4 * g] + L1[4 * g + 1]) + (L1[4 * g + 2] + L1[4 * g + 3]); }
#pragma unroll
            for (int g = 0; g < 8; ++g) pg[g] = xchg32(gs[g], hi);
            float run = 0.f;
#pragma unroll
            for (int g = 7; g >= 0; --g) { after[g] = run + (hi == 0 ? pg[g] : 0.f); run += gs[g] + pg[g]; }
#pragma unroll
            for (int g = 0; g < 4; ++g) {
                { const float s3 = after[g] + carry, s2 = s3 + L0[4 * g + 3], s1 = s2 + L0[4 * g + 2], s0 = s1 + L0[4 * g + 1];
                  const int c = 8 * g;
                  p0[4 * g + 0] = (dq - (c + 0) > 0) ? __expf(p0[4 * g + 0] + s0) : 0.f; p0[4 * g + 1] = (dq - (c + 1) > 0) ? __expf(p0[4 * g + 1] + s1) : 0.f;
                  p0[4 * g + 2] = (dq - (c + 2) > 0) ? __expf(p0[4 * g + 2] + s2) : 0.f; p0[4 * g + 3] = (dq - (c + 3) > 0) ? __expf(p0[4 * g + 3] + s3) : 0.f; }
                { const float s3 = after[4 + g] + carry, s2 = s3 + L1[4 * g + 3], s1 = s2 + L1[4 * g + 2], s0 = s1 + L1[4 * g + 1];
                  const int c = 8 * g + 32;
                  p1[4 * g + 0] = (dq - (c + 0) > 0) ? __expf(p1[4 * g + 0] + s0) : 0.f; p1[4 * g + 1] = (dq - (c + 1) > 0) ? __expf(p1[4 * g + 1] + s1) : 0.f;
                  p1[4 * g + 2] = (dq - (c + 2) > 0) ? __expf(p1[4 * g + 2] + s2) : 0.f; p1[4 * g + 3] = (dq - (c + 3) > 0) ? __expf(p1[4 * g + 3] + s3) : 0.f; }
            }
            carry += run;
            packP(p0, p1, pa0, pa1, pa2, pa3);
            pv_tile(o, vb0, pa0, pa1, pa2, pa3);
            if (__all(carry < -105.f)) { wdone = true; if (lane == 0) wflag[wid] = 1; }
        }
    }
    attn_store(o, ws, A, r32, hi, false, 1.f);
    __syncthreads();
}


constexpr int IXQ_LD = 2064;
constexpr int IXQ_TILE = 32 * IXQ_LD + 2048;
__device__ __forceinline__ void indexer_pair(const Ctx& C, int b, int i) {
    const bf16_t* proj = (const bf16_t*)(C.ws + WS_PROJ); float* scores = (float*)(C.ws + WS_SC);
    const int tid = C.tid, lane = C.lane, wid = C.wave, r32 = lane & 31, hi = lane >> 5;
    __syncthreads();
    {
        u32x4 tq[2][8]; float wq[2];
#pragma unroll
        for (int blk = 0; blk < 2; ++blk) {
            const size_t trow0 = (size_t)b * SEQ + (blk ? i : 63 - i) * 32;
#pragma unroll
            for (int j = 0; j < 8; ++j) { const int ch = tid + 512 * j, row = ch >> 7, c = ch & 127; tq[blk][j] = *(const u32x4*)(proj + (trow0 + row) * NPROJ + O_IXQ + c * 8); }
            wq[blk] = bf2f(proj[(trow0 + (tid >> 4)) * NPROJ + O_IXW + (tid & 15)]) * 0.03125f;
        }
#pragma unroll
        for (int blk = 0; blk < 2; ++blk) {
#pragma unroll
            for (int j = 0; j < 8; ++j) { const int ch = tid + 512 * j, row = ch >> 7, c = ch & 127; *(LAS u32x4*)(C.ldsl + blk * IXQ_TILE + row * IXQ_LD + c * 16) = tq[blk][j]; }
            ((LAS float*)(C.ldsl + blk * IXQ_TILE + 32 * IXQ_LD))[tid] = wq[blk];
        }
    }
    __syncthreads();
    const int ntB = ((63 - i) * 32 + 31) / 64 + 1, ntA = (i * 32 + 31) / 64 + 1, ntot = ntB + ntA;
    const bf16_t* kix = proj + (size_t)b * SEQ * NPROJ + O_IXK;
    bf16x8 kf[2][4], kn[2][4];
    { const int kb = ((wid < ntB) ? wid : wid - ntB) * 64;
      if (wid < ntot) {
#pragma unroll
        for (int hf = 0; hf < 2; ++hf)
#pragma unroll
            for (int ks = 0; ks < 4; ++ks) kn[hf][ks] = *(const bf16x8*)(kix + (size_t)(kb + hf * 32 + r32) * NPROJ + ks * 16 + hi * 8); } }
    for (int it = wid; it < ntot; it += NWAVES) {
        const int blk = (it < ntB) ? 0 : 1, t = blk ? it - ntB : it, kb = t * 64;
#pragma unroll
        for (int hf = 0; hf < 2; ++hf)
#pragma unroll
            for (int ks = 0; ks < 4; ++ks) kf[hf][ks] = kn[hf][ks];
        const int itn = it + NWAVES;
        if (itn < ntot) { const int kbn = ((itn < ntB) ? itn : itn - ntB) * 64;
#pragma unroll
            for (int hf = 0; hf < 2; ++hf)
#pragma unroll
                for (int ks = 0; ks < 4; ++ks) kn[hf][ks] = *(const bf16x8*)(kix + (size_t)(kbn + hf * 32 + r32) * NPROJ + ks * 16 + hi * 8); }
        const LAS unsigned char* qt = C.ldsl + blk * IXQ_TILE + r32 * IXQ_LD + hi * 16;
        const LAS float* wt = (const LAS float*)(C.ldsl + blk * IXQ_TILE + 32 * IXQ_LD) + r32 * 16;
        f32x16 a0 = {}, a1 = {}, sA0 = {}, sA1 = {}, sB0, sB1;
#define IX_MMA(S0, S1, h) do { _Pragma("unroll") for (int ks = 0; ks < 4; ++ks) { const bf16x8 qf = *(const LAS bf16x8*)(qt + (h) * 128 + ks * 32); \
            S0 = __builtin_amdgcn_mfma_f32_32x32x16_bf16(kf[0][ks], qf, S0, 0, 0, 0); S1 = __builtin_amdgcn_mfma_f32_32x32x16_bf16(kf[1][ks], qf, S1, 0, 0, 0); } } while (0)
#define IX_RELU(x) __int_as_float(max(__float_as_int(x), 0))
#define IX_ACC(S0, S1, h) do { const float w_ = wt[h]; _Pragma("unroll") for (int r = 0; r < 16; ++r) { a0[r] = fmaf(w_, IX_RELU(S0[r]), a0[r]); a1[r] = fmaf(w_, IX_RELU(S1[r]), a1[r]); } } while (0)
        IX_MMA(sA0, sA1, 0);
#pragma unroll 1
        for (int h = 0; h < 16; h += 2) {
            sB0 = f32x16{}; sB1 = f32x16{}; IX_MMA(sB0, sB1, h + 1);
            IX_ACC(sA0, sA1, h);
            sA0 = f32x16{}; sA1 = f32x16{}; if (h + 2 < 16) IX_MMA(sA0, sA1, h + 2);
            IX_ACC(sB0, sB1, h + 1);
        }
#undef IX_MMA
#undef IX_ACC
        const size_t trow0 = (size_t)b * SEQ + (blk ? i : 63 - i) * 32;
        float* srow = scores + (trow0 + r32) * SEQ + kb + 4 * hi;
#pragma unroll
        for (int g = 0; g < 4; ++g) { *(f32x4*)(srow + 8 * g) = (f32x4){a0[4 * g], a0[4 * g + 1], a0[4 * g + 2], a0[4 * g + 3]};
                                      *(f32x4*)(srow + 32 + 8 * g) = (f32x4){a1[4 * g], a1[4 * g + 1], a1[4 * g + 2], a1[4 * g + 3]}; }
    }
}
__device__ __forceinline__ void phase_indexer(const Ctx& C) {
    for (int it = C.bid; it < NB * 32; it += C.G) indexer_pair(C, it >> 5, it & 31);
    __syncthreads();
}

template <int NR>
__device__ __forceinline__ int sel_count_ge(const unsigned (&u)[NR], unsigned trial) {
    int c = 0;
#pragma unroll
    for (int j = 0; j < NR; ++j) asm volatile("v_cmp_le_u32 vcc, %1, %2\n\tv_addc_co_u32 %0, vcc, 0, %0, vcc" : "+v"(c) : "s"(trial), "v"(u[j]) : "vcc");
    return wave_sum_i(c);
}
template <int NR>
__device__ __forceinline__ unsigned long long sel_row(const float* srow, int qpos, int lane, LAS unsigned* scr) {
    const int ntile = (qpos >> 6) + 1;
    unsigned u[NR];
#pragma unroll
    for (int j = 0; j < NR; ++j) { const int key = j * 64 + lane; unsigned v = 0u;
        if (j < ntile) { const unsigned bits = __float_as_uint(srow[key]); v = (key <= qpos) ? (bits ^ ((bits >> 31) ? 0xFFFFFFFFu : 0x80000000u)) : 0u; }
        u[j] = v; }
    unsigned long long myword = 0ull;
    unsigned prefix = 0u; int clo = qpos + 1, chi = 0, bit = 31;
#pragma unroll 1
    for (; bit >= 0; --bit) {
        const unsigned trial = prefix | (1u << bit); const int cnt = sel_count_ge<NR>(u, trial);
        if (cnt >= 256) { prefix = trial; clo = cnt; } else { chi = cnt; }
        if (clo - chi <= 64) break;
    }
    if (bit > 0) {
        const unsigned span = 1u << bit; const int need0 = 256 - chi;
        int slot = 0;
#pragma unroll
        for (int j = 0; j < NR; ++j) { const bool in = (u[j] - prefix) < span && u[j] != 0u; const unsigned long long m = __ballot(in);
            if (m != 0ull) { const int pos = slot + __popcll(m & ((1ull << lane) - 1ull)); if (in && pos < 64) scr[pos] = u[j]; slot += __popcll(m); } }
        LDS_WAIT();
        const unsigned c = (lane < slot) ? scr[lane] : 0u;
#pragma unroll 1
        for (int b2 = bit - 1; b2 >= 0; --b2) { const unsigned trial = prefix | (1u << b2); const int cnt = __popcll(__ballot(c >= trial)); if (cnt >= need0) prefix = trial; }
    }
    int tot = 0; unsigned long long gew[NR];
#pragma unroll
    for (int j = 0; j < NR; ++j) { gew[j] = __ballot(u[j] >= prefix); tot += __popcll(gew[j]); }
    if (tot == 256) {
#pragma unroll
        for (int j = 0; j < NR; ++j) myword = (lane == j) ? gew[j] : myword;
    } else {
        int ngt = 0;
#pragma unroll
        for (int j = 0; j < NR; ++j) ngt += __popcll(__ballot(u[j] > prefix));
        int need = 256 - ngt;
#pragma unroll
        for (int j = 0; j < NR; ++j) {
            const unsigned long long gt = __ballot(u[j] > prefix); unsigned long long eq = __ballot(u[j] == prefix);
            int ne = __popcll(eq);
            if (ne > need) { while (ne > need) { eq &= ~(1ull << (63 - __clzll(eq))); --ne; } }
            need -= ne;
            const unsigned long long m = gt | eq; myword = (lane == j) ? m : myword;
        }
    }
    return myword;
}
__device__ __forceinline__ void phase_select(const Ctx& C) {
    const float* scores = (const float*)(C.ws + WS_SC); unsigned long long* mask = (unsigned long long*)(C.ws + WS_MASK);
    const int lane = C.lane;
    LAS unsigned* scr = (LAS unsigned*)(C.ldsl + 96 * 1024 + C.wave * 256);
    for (int t0 = C.gw, it = 0; t0 < T; t0 += C.NGW, ++it) {
        const int t = (it & 1) ? ((t0 & ~(SEQ - 1)) | (SEQ - 1 - (t0 & (SEQ - 1)))) : t0;
        const int qpos = t & (SEQ - 1);
        const float* srow = scores + (size_t)t * SEQ;
        unsigned long long myword = 0ull;
        if (qpos < 256) {
#pragma unroll
            for (int j = 0; j < 4; ++j) { const int key = j * 64 + lane; const unsigned long long m = __ballot(key <= qpos); myword = (lane == j) ? m : myword; }
        } else if (qpos < 512) myword = sel_row<8>(srow, qpos, lane, scr);
        else if (qpos < 768) myword = sel_row<12>(srow, qpos, lane, scr);
        else if (qpos < 1024) myword = sel_row<16>(srow, qpos, lane, scr);
        else if (qpos < 1280) myword = sel_row<20>(srow, qpos, lane, scr);
        else if (qpos < 1536) myword = sel_row<24>(srow, qpos, lane, scr);
        else if (qpos < 1792) myword = sel_row<28>(srow, qpos, lane, scr);
        else myword = sel_row<32>(srow, qpos, lane, scr);
        if (lane < 32) mask[(size_t)t * 32 + lane] = myword;
    }
}

constexpr int RT_LD = 4112;
__device__ __forceinline__ void phase_router(const Ctx& C, int l, const bf16_t* x1, bool commit = true) {
    const float* g = C.ap->in[I_NFG] + (size_t)l * DM; const float* mod = (const float*)(C.ws + WS_MOD) + (size_t)l * NB * 6 * DM;
    const float* msh = mod + 3 * DM; const float* msc = mod + 4 * DM;
    bf16_t* h2 = (bf16_t*)(C.ws + WS_H); unsigned char* h2f8 = C.ws + WS_H8;
    const bf16_t* WrT = (const bf16_t*)(C.ws + WS_W + (size_t)l * LW_BYTES + LW_R);
    const float* brt = C.ap->in[I_BR] + (size_t)l * NE;
    unsigned* gcnt = (unsigned*)(C.ws + WS_CTL) + CW_CNT + l * 64;
    int* rte = (int*)(C.ws + WS_RTE); int* rts = (int*)(C.ws + WS_RTS); float* rtg = (float*)(C.ws + WS_RTG); int* slot_tok = (int*)(C.ws + WS_ST);
    const int tid = C.tid, lane = C.lane, wid = C.wave, r32 = lane & 31, hi = lane >> 5;
    LAS float* part = (LAS float*)C.ldsl;
    LAS float* logit = (LAS float*)(C.ldsl + 65536);
    LAS float* work = (LAS float*)(C.ldsl + 65536 + 8192);
    LAS int* lcnt = (LAS int*)(C.ldsl + 136 * 1024);
    LAS int* lbase = lcnt + 64;
    for (int tile = C.bid; tile < T / 32; tile += C.G) {
        const int tok0 = tile * 32, b = tok0 / SEQ;
        __syncthreads();
        {
            f32x4 a[4][2], s[4][2];
#pragma unroll
            for (int j = 0; j < 4; ++j)
#pragma unroll
                for (int q = 0; q < 2; ++q) { const int col = 8 * lane + 512 * j + 4 * q; const f32x4 gg = *(const f32x4*)(g + col), sc = *(const f32x4*)(msc + (size_t)b * 6 * DM + col);
                    a[j][q] = gg * (sc + 1.f); s[j][q] = *(const f32x4*)(msh + (size_t)b * 6 * DM + col); }
            u32x4 xw[4][4];
#pragma unroll
            for (int r = 0; r < 4; ++r)
#pragma unroll
                for (int j = 0; j < 4; ++j) xw[r][j] = *(const u32x4*)(x1 + (size_t)(tok0 + wid * 4 + r) * DM + 8 * lane + 512 * j);
#pragma unroll
            for (int r = 0; r < 4; ++r) {
                const int row = wid * 4 + r;
                f32x4 v[4][2]; float ss = 0.f;
#pragma unroll
                for (int j = 0; j < 4; ++j) { v[j][0] = (f32x4){bflo(xw[r][j].x), bfhi(xw[r][j].x), bflo(xw[r][j].y), bfhi(xw[r][j].y)}; v[j][1] = (f32x4){bflo(xw[r][j].z), bfhi(xw[r][j].z), bflo(xw[r][j].w), bfhi(xw[r][j].w)};
                    ss += ((v[j][0][0] * v[j][0][0] + v[j][0][1] * v[j][0][1]) + (v[j][0][2] * v[j][0][2] + v[j][0][3] * v[j][0][3])) + ((v[j][1][0] * v[j][1][0] + v[j][1][1] * v[j][1][1]) + (v[j][1][2] * v[j][1][2] + v[j][1][3] * v[j][1][3])); }
                const float rstd = rsqrtf(wave_sum(ss) * (1.f / DM) + EPS);
                bf16_t* hr = h2 + (size_t)(tok0 + row) * DM;
#pragma unroll
                for (int j = 0; j < 4; ++j) { const f32x4 y0 = v[j][0] * rstd * a[j][0] + s[j][0], y1 = v[j][1] * rstd * a[j][1] + s[j][1];
                    u32x4 w; w.x = cvtpk(y0[0], y0[1]); w.y = cvtpk(y0[2], y0[3]); w.z = cvtpk(y1[0], y1[1]); w.w = cvtpk(y1[2], y1[3]);
                    if (!SH_FP8) *(u32x4*)(hr + 8 * lane + 512 * j) = w;
                    *(LAS u32x4*)(C.ldsl + row * RT_LD + (8 * lane + 512 * j) * 2) = w;
                    u32x2 w8; w8.x = pk4_fp8(y0[0], y0[1], y0[2], y0[3]); w8.y = pk4_fp8(y1[0], y1[1], y1[2], y1[3]);
                    *(u32x2*)(h2f8 + (size_t)(tok0 + row) * DM + 8 * lane + 512 * j) = w8; }
            }
        }
        if (tid < 64) lcnt[tid] = 0;
        __syncthreads();
        f32x16 acc0 = {}, acc1 = {};
        {
            const int kw = wid * 256;
#pragma unroll 8
            for (int ks = 0; ks < 16; ++ks) {
                const bf16x8 af = *(const LAS bf16x8*)(C.ldsl + r32 * RT_LD + (kw + ks * 16 + hi * 8) * 2);
                const bf16x8 b0 = *(const bf16x8*)(WrT + (size_t)r32 * DM + kw + ks * 16 + hi * 8);
                const bf16x8 b1 = *(const bf16x8*)(WrT + (size_t)(32 + r32) * DM + kw + ks * 16 + hi * 8);
                acc0 = __builtin_amdgcn_mfma_f32_32x32x16_bf16(af, b0, acc0, 0, 0, 0);
                acc1 = __builtin_amdgcn_mfma_f32_32x32x16_bf16(af, b1, acc1, 0, 0, 0);
            }
        }
        __syncthreads();
#pragma unroll
        for (int r = 0; r < 16; ++r) { const int tk = crow(r, hi); part[(wid * 32 + tk) * 64 + r32] = acc0[r]; part[(wid * 32 + tk) * 64 + 32 + r32] = acc1[r]; }
        __syncthreads();
#pragma unroll
        for (int j = 0; j < 4; ++j) { const int idx = tid + 512 * j; float sacc = 0.f;
#pragma unroll
            for (int w = 0; w < 8; ++w) sacc += part[w * 2048 + idx];
            logit[idx] = sacc; }
        __syncthreads();
        if (!commit) continue;
        int rk[4], sl[4]; float gk[4];
        const float bias_e = brt[lane];
#pragma unroll
        for (int q = 0; q < 4; ++q) {
            const int tk = wid * 4 + q;
            const float sg = 1.f / (1.f + __expf(-logit[tk * 64 + lane])); const float bv = sg + bias_e;
            float m1 = bv; m1 = fmaxf(m1, __shfl_xor(m1, 1)); m1 = fmaxf(m1, __shfl_xor(m1, 2)); m1 = fmaxf(m1, __shfl_xor(m1, 4));
            const unsigned long long eqm = __ballot(bv == m1) >> (lane & ~7);
            const int first = __ffsll((long long)(eqm & 0xffull)) - 1;
            float m2 = ((lane & 7) == first) ? -__builtin_inff() : bv; m2 = fmaxf(m2, __shfl_xor(m2, 1)); m2 = fmaxf(m2, __shfl_xor(m2, 2)); m2 = fmaxf(m2, __shfl_xor(m2, 4));
            const float grp = m1 + m2; const int gi = lane >> 3;
            int grank = 0;
#pragma unroll
            for (int gj = 0; gj < 8; ++gj) { const float og = __shfl(grp, gj * 8); grank += (og > grp || (og == grp && gj < gi)) ? 1 : 0; }
            const float mv = (grank < 4) ? bv : -__builtin_inff();
            int rank = 0;
#pragma unroll 8
            for (int e2 = 0; e2 < 64; ++e2) { const float ov = __shfl(mv, e2); rank += (ov > mv || (ov == mv && e2 < lane)) ? 1 : 0; }
            const bool chosen = rank < 8;
            float gs = chosen ? sg : 0.f; gs = wave_sum(gs);
            rk[q] = chosen ? rank : -1; gk[q] = sg * (2.5f / gs);
            sl[q] = chosen ? __hip_atomic_fetch_add(&lcnt[lane], 1, __ATOMIC_RELAXED, __HIP_MEMORY_SCOPE_WORKGROUP) : 0;
        }
        __syncthreads();
        if (tid < 64) { const int n = lcnt[tid]; lbase[tid] = n ? (int)atomicAdd(&gcnt[tid], (unsigned)n) : 0; }
        __syncthreads();
        { const int base = lbase[lane];
#pragma unroll
          for (int q = 0; q < 4; ++q) if (rk[q] >= 0) { const int tok = tok0 + wid * 4 + q, slot = base + sl[q];
              slot_tok[(size_t)lane * T + slot] = tok; rte[tok * 8 + rk[q]] = lane; rts[tok * 8 + rk[q]] = slot; rtg[tok * 8 + rk[q]] = gk[q]; } }
    }
    __syncthreads();
}

__device__ __forceinline__ void moe_tables(const Ctx& C, int l) {
    const unsigned* gcnt = (const unsigned*)(C.ws + WS_CTL) + CW_CNT + l * 64;
    LAS int* cnt = (LAS int*)(C.ldsl + LDS_TAB); LAS int* ptile = cnt + 64;
    __syncthreads();
    if (C.tid == 0) { int acc = 0; for (int e = 0; e < NE; ++e) { const int n = (int)gcnt[e]; cnt[e] = n; ptile[e] = acc; acc += (n + 255) >> 8; } ptile[NE] = acc; }
    __syncthreads();
    LAS int* pexp = ptile + 80;
    for (int p = C.tid; p < PMAX / 256; p += NTHR) { int e = 0; for (int j = 1; j < NE; ++j) e += (ptile[j] <= p) ? 1 : 0;
        const int pi = p - ptile[e], left = cnt[e] - pi * 256, vr = left < 1 ? 1 : (left > 256 ? 256 : left);
        pexp[p] = e | (pi << 8) | (vr << 16); }
    __syncthreads();
}

template <int MODE>
__device__ __forceinline__ void phase_combine(const Ctx& C, int l, const bf16_t* x1, bf16_t* x2) {
    const unsigned* gcnt = (const unsigned*)(C.ws + WS_CTL) + CW_CNT + l * 64;
    const float* mod = (const float*)(C.ws + WS_MOD) + (size_t)l * NB * 6 * DM; const float* mgf = mod + 5 * DM;
    const unsigned char* y = C.ws + WS_Y; const unsigned char* ys = C.ws + WS_YS;
    const int* rte = (const int*)(C.ws + WS_RTE); const int* rts = (const int*)(C.ws + WS_RTS); const float* rtg = (const float*)(C.ws + WS_RTG);
    const int lane = C.lane;
    int pt; { const int n = (int)gcnt[lane]; const int tl = (n + 255) >> 8; int inc = tl;
#pragma unroll
        for (int o = 1; o < 64; o <<= 1) { const int v = __shfl_up(inc, o); if (lane >= o) inc += v; }
        pt = inc - tl; }
    const float* gN = (MODE == 0) ? C.ap->in[I_NMG] + (size_t)(l + 1) * DM : C.ap->in[I_FG];
    const float* modN = (const float*)(C.ws + WS_MOD) + (size_t)(l + 1) * NB * 6 * DM;
    unsigned char* h8 = C.ws + WS_H8; bf16_t* h = (bf16_t*)(C.ws + WS_H);
    for (int chunk = C.gw; chunk < T / 8; chunk += C.NGW) {
        const int row0 = chunk * 8, b = row0 / SEQ;
        f32x4 gfv[4][2], anv[4][2];
#pragma unroll
        for (int j = 0; j < 4; ++j)
#pragma unroll
            for (int q = 0; q < 2; ++q) { const int col = 8 * lane + 512 * j + 4 * q; const f32x4 gg = *(const f32x4*)(gN + col);
                gfv[j][q] = *(const f32x4*)(mgf + (size_t)b * 6 * DM + col);
                if (MODE == 0) anv[j][q] = gg * (*(const f32x4*)(modN + (size_t)b * 6 * DM + DM + col) + 1.f); else anv[j][q] = gg; }
        int yrow_l; float gate_l;
        { const int e = rte[row0 * 8 + lane], slot = rts[row0 * 8 + lane]; gate_l = rtg[row0 * 8 + lane] * (1.f / Y_SCALE); yrow_l = __shfl(pt, e) * 256 + slot; }
#pragma unroll 1
        for (int r = 0; r < 8; ++r) {
            const int t = row0 + r;
            const unsigned char* yr[8]; float gk[8];
#pragma unroll
            for (int k = 0; k < 8; ++k) { const int yrow = __builtin_amdgcn_readlane(yrow_l, r * 8 + k); gk[k] = __int_as_float(__builtin_amdgcn_readlane(__float_as_int(gate_l), r * 8 + k));
#if Y_TILED
                yr[k] = y + (size_t)((unsigned)(yrow >> 8) * (unsigned)(DM * 256) + (unsigned)(yrow & 255) * 256u) + (size_t)((lane >> 5) * 65536 + ((8 * lane) & 255)); }
#else
                yr[k] = y + (size_t)(unsigned)yrow * DM + 8 * lane; }
#endif
            f32x4 acc[4][2]; float ss = 0.f;
#pragma unroll
            for (int h2 = 0; h2 < 2; ++h2) {
                u32x2 yv[8][2], ysv[2]; u32x4 xw[2]; f32x4 xv[2][2];
#pragma unroll
                for (int k = 0; k < 8; ++k)
#pragma unroll
                    for (int jj = 0; jj < 2; ++jj) yv[k][jj] = *(const u32x2*)(yr[k] + (Y_TILED ? 131072 : 512) * (2 * h2 + jj));
#pragma unroll
                for (int jj = 0; jj < 2; ++jj) { const int col = 8 * lane + 512 * (2 * h2 + jj);
                    ysv[jj] = Y_TILED ? *(const u32x2*)(ys + (size_t)((unsigned)(t >> 8) * (unsigned)(DM * 256) + (unsigned)(t & 255) * 256u) + (size_t)((lane >> 5) * 65536 + ((8 * lane) & 255)) + 131072 * (2 * h2 + jj))
                                      : *(const u32x2*)(ys + (size_t)t * DM + col);
                    xw[jj] = *(const u32x4*)(x1 + (size_t)t * DM + col); }
#pragma unroll
                for (int jj = 0; jj < 2; ++jj) {
                    f32x4 a0, a1; { const f32x2 q0 = __builtin_amdgcn_cvt_pk_f32_fp8((int)ysv[jj].x, false), q1 = __builtin_amdgcn_cvt_pk_f32_fp8((int)ysv[jj].x, true), q2 = __builtin_amdgcn_cvt_pk_f32_fp8((int)ysv[jj].y, false), q3 = __builtin_amdgcn_cvt_pk_f32_fp8((int)ysv[jj].y, true);
                        a0 = (f32x4){q0[0], q0[1], q1[0], q1[1]} * (1.f / Y_SCALE); a1 = (f32x4){q2[0], q2[1], q3[0], q3[1]} * (1.f / Y_SCALE); }
#pragma unroll
                    for (int k = 0; k < 8; ++k) { const u32x2 w = yv[k][jj]; const float gt = gk[k];
                        const f32x2 p0 = __builtin_amdgcn_cvt_pk_f32_fp8((int)w.x, false), p1 = __builtin_amdgcn_cvt_pk_f32_fp8((int)w.x, true), p2 = __builtin_amdgcn_cvt_pk_f32_fp8((int)w.y, false), p3 = __builtin_amdgcn_cvt_pk_f32_fp8((int)w.y, true);
                        a0[0] = fmaf(gt, p0[0], a0[0]); a0[1] = fmaf(gt, p0[1], a0[1]); a0[2] = fmaf(gt, p1[0], a0[2]); a0[3] = fmaf(gt, p1[1], a0[3]);
                        a1[0] = fmaf(gt, p2[0], a1[0]); a1[1] = fmaf(gt, p2[1], a1[1]); a1[2] = fmaf(gt, p3[0], a1[2]); a1[3] = fmaf(gt, p3[1], a1[3]); }
                    xv[jj][0] = (f32x4){bflo(xw[jj].x), bfhi(xw[jj].x), bflo(xw[jj].y), bfhi(xw[jj].y)}; xv[jj][1] = (f32x4){bflo(xw[jj].z), bfhi(xw[jj].z), bflo(xw[jj].w), bfhi(xw[jj].w)};
                    a0 = xv[jj][0] + gfv[2 * h2 + jj][0] * a0; a1 = xv[jj][1] + gfv[2 * h2 + jj][1] * a1;
                    ss += ((a0[0] * a0[0] + a0[1] * a0[1]) + (a0[2] * a0[2] + a0[3] * a0[3])) + ((a1[0] * a1[0] + a1[1] * a1[1]) + (a1[2] * a1[2] + a1[3] * a1[3]));
                    acc[2 * h2 + jj][0] = a0; acc[2 * h2 + jj][1] = a1; }
            }
            const float rstd = rsqrtf(wave_sum(ss) * (1.f / DM) + EPS);
#pragma unroll
            for (int j = 0; j < 4; ++j) { const int col = 8 * lane + 512 * j;
                if (MODE == 0) { { u32x4 xo; xo.x = cvtpk(acc[j][0][0], acc[j][0][1]); xo.y = cvtpk(acc[j][0][2], acc[j][0][3]); xo.z = cvtpk(acc[j][1][0], acc[j][1][1]); xo.w = cvtpk(acc[j][1][2], acc[j][1][3]); *(u32x4*)(x2 + (size_t)t * DM + col) = xo; }
                    const f32x4 y0 = acc[j][0] * rstd * anv[j][0] + *(const f32x4*)(modN + (size_t)b * 6 * DM + col), y1 = acc[j][1] * rstd * anv[j][1] + *(const f32x4*)(modN + (size_t)b * 6 * DM + col + 4);
                    if (WIN_FP8 != 0) { u32x2 w8; w8.x = pk4_fp8(y0[0], y0[1], y0[2], y0[3]); w8.y = pk4_fp8(y1[0], y1[1], y1[2], y1[3]); *(u32x2*)(h8 + (size_t)t * DM + col) = w8; }
                    if (WIN_FP8 != 1) { u32x4 w; w.x = cvtpk(y0[0], y0[1]); w.y = cvtpk(y0[2], y0[3]); w.z = cvtpk(y1[0], y1[1]); w.w = cvtpk(y1[2], y1[3]); *(u32x4*)(h + (size_t)t * DM + col) = w; } }
                else { *(f32x4*)(C.out + (size_t)t * DM + col) = acc[j][0] * rstd * anv[j][0]; *(f32x4*)(C.out + (size_t)t * DM + col + 4) = acc[j][1] * rstd * anv[j][1]; } }
        }
    }
}

#define OPTR(base, idx) (WO_FP8 ? (bf16_t*)((unsigned char*)(base) + (size_t)(idx)) : ((base) + (size_t)(idx)))
__device__ __forceinline__ void phase_attn_mla(const Ctx& C, int l, int vcu) {
    const bf16_t* qbuf = (const bf16_t*)(C.ws + WS_Q); const bf16_t* kvbuf = (const bf16_t*)(C.ws + WS_KV); const bf16_t* proj = (const bf16_t*)(C.ws + WS_PROJ);
    const float* cs = (const float*)(C.ws + WS_CS); bf16_t* obuf = (bf16_t*)(C.ws + WS_O); const float* gout = C.ap->in[I_GOUT] + (size_t)l * DM;
    for (int it = vcu; it < NB * 8 * 4; it += C.G) {
        const int b = it >> 5, h = (it >> 2) & 7, i = it & 3;
#pragma unroll 1
        for (int pass = 0; pass < 2; ++pass) {
            const int qb = pass ? i : 7 - i, q0 = qb * 256, qlo = q0 + 32 * C.wave; const size_t trow = (size_t)b * SEQ + qlo;
            AttnWave A;
            A.Q = qbuf + trow * 1536 + h * 192; A.ldq = 1536; A.cs = cs + trow * 64;
            A.K = kvbuf + (size_t)b * SEQ * 2048 + h * 256; A.ldk = 2048; A.KR = proj + (size_t)b * SEQ * NPROJ + O_KR; A.ldkr = NPROJ;
            A.V = kvbuf + (size_t)b * SEQ * 2048 + h * 256 + 128; A.ldv = 2048; A.mw = nullptr;
            A.O = OPTR(obuf, trow * DM + h * 128); A.ldo = DM; A.gout = gout + h * 128; A.qlo = qlo; A.nt_w = (qlo + 31) / 64 + 1;
            attn_softmax_block<0>(C.ldsl, C.tid, A, (q0 + 255) / 64 + 1, 0.07216878364870322f);
        }
    }
}
__device__ __forceinline__ void phase_attn_sb(const Ctx& C, int l, int vcu) {
    const bf16_t* proj = (const bf16_t*)(C.ws + WS_PROJ); bf16_t* obuf = (bf16_t*)(C.ws + WS_O); const float* gout = C.ap->in[I_GOUT] + (size_t)l * DM;
    for (int it = vcu; it < NB * 4 * 8; it += C.G) {
        const int b = it >> 5, h = (it >> 3) & 3, qb = 7 - (it & 7), q0 = qb * 256, qlo = q0 + 32 * C.wave; const size_t trow = (size_t)b * SEQ + qlo;
        AttnWave A;
        A.Q = proj + trow * NPROJ + O_SBQ + h * 128; A.ldq = NPROJ; A.cs = nullptr;
        A.K = proj + (size_t)b * SEQ * NPROJ + O_SBK + h * 128; A.ldk = NPROJ; A.KR = nullptr; A.ldkr = 0;
        A.V = proj + (size_t)b * SEQ * NPROJ + O_SBV + h * 128; A.ldv = NPROJ; A.mw = nullptr;
        A.O = OPTR(obuf, trow * DM + (8 + h) * 128); A.ldo = DM; A.gout = gout + (8 + h) * 128; A.qlo = qlo; A.nt_w = (qlo + 30) / 64 + 1;
        attn_sb_block(C.ldsl, C.tid, A, (q0 + 254) / 64 + 1, 0.08838834764831845f);
    }
}
__device__ __forceinline__ void phase_attn_dsa(const Ctx& C, int l, int vcu) {
    const bf16_t* proj = (const bf16_t*)(C.ws + WS_PROJ); bf16_t* obuf = (bf16_t*)(C.ws + WS_O); const float* gout = C.ap->in[I_GOUT] + (size_t)l * DM;
    const unsigned long long* mask = (const unsigned long long*)(C.ws + WS_MASK);
    for (int it = vcu; it < NB * 32; it += C.G) {
        const int b = it >> 5, i = it & 31, head = C.wave & 3;
#pragma unroll 1
        for (int pass = 0; pass < 2; ++pass) {
            const int qblk = pass ? i : 63 - i, q0 = qblk * 32; const size_t trow = (size_t)b * SEQ + q0;
            AttnWave A;
            A.Q = proj + trow * NPROJ + O_DSQ + head * 128; A.ldq = NPROJ; A.cs = nullptr;
            A.K = proj + (size_t)b * SEQ * NPROJ + O_DSK; A.ldk = NPROJ; A.KR = nullptr; A.ldkr = 0;
            A.V = proj + (size_t)b * SEQ * NPROJ + O_DSV; A.ldv = NPROJ; A.mw = mask + trow * 32;
            A.O = OPTR(obuf, trow * DM + (12 + head) * 128); A.ldo = DM; A.gout = gout + (12 + head) * 128; A.qlo = q0; A.nt_w = (q0 + 31) / 64 + 1;
            attn_dsa_block(C.ldsl, C.tid, A, (q0 + 31) / 64 + 1, 0.08838834764831845f);
        }
    }
}

constexpr int NPHASE = 2 + 10 * NL;
#ifndef PHMASK
#define PHMASK 0xFFFFFFFFu
#endif
#define EN(j) ((PHMASK >> (j)) & 1u)
#ifndef REPMASK
#define REPMASK 0u
#endif
#define NREP(j) (1 + (int)((REPMASK >> (j)) & 1u))
#define WSP(T_, off) ((T_*)(C.ws + (off)))
__global__ void __launch_bounds__(NTHR, 2) fwd(Args args) {
    extern __shared__ __attribute__((aligned(16))) unsigned char lds[];
    const int lo = args.ph_lo, hi = args.ph_hi;
    const int wave_s = __builtin_amdgcn_readfirstlane((int)threadIdx.x >> 6);
    if (threadIdx.x < 64) ((LAS unsigned*)((LAS unsigned char*)lds + LDS_MISC))[threadIdx.x] = 0u;
    __syncthreads();
    XcdBarrier bar; bar.bar = (unsigned*)(args.ws + WS_CTL); bar.x = 0; bar.st = (volatile LAS unsigned*)((LAS unsigned char*)lds + LDS_MISC);
    if (hi - lo > 1) bar = xcd_barrier_post((unsigned*)(args.ws + WS_CTL), (volatile LAS unsigned*)((LAS unsigned char*)lds + LDS_MISC), wave_s);
#define IN(k) (lo <= (k) && (k) < hi)
#ifndef SEAMREP
#define SEAMREP 1
#endif
#define SEAM(k) do { if (lo <= (k) && (k) + 1 < hi) { for (int sr_ = 0; sr_ < SEAMREP; ++sr_) xcd_barrier(bar, wave_s); } } while (0)
#define SECTION() asm volatile("; SECMARK %0" :: "i"(__LINE__)); Ctx C; ctx_init(C, lds, wave_s)
#ifndef NO_FILL
#define FILL() do { if (hi - lo > 1) { ++nfill; SECTION(); cvt_fill(C, (unsigned)(nfill * (int)gridDim.x)); } } while (0)
#else
#define FILL() do { } while (0)
#endif
    int nfill = 0;

    if (EN(0) && IN(0)) { for (int ra = 0; ra < NREP(1); ++ra) { SECTION(); phase_adaln(C); __syncthreads(); } __syncthreads(); for (int rp = 0; rp < NREP(0); ++rp) { SECTION(); phase_convert(C); }
#ifdef USE_FILL0
        FILL();
#endif
        SEAM(0); }
    if (EN(1) && IN(1)) { SECTION(); const float* modp = WSP(float, WS_MOD);
        for (int chunk = C.gw; chunk < T / 8; chunk += C.NGW) norm_mod_rows(C.ap->in[I_X], C.ap->in[I_NMG], modp, modp + DM, C.ws + WS_H8, WSP(bf16_t, WS_H), chunk * 8, 8, C.lane);
        SEAM(1); }
#pragma unroll 1
    for (int l = 0; l < NL; ++l) {
        const int pb = 2 + 10 * l;
        if (EN(2) && IN(pb + 0)) {
            SECTION(); unsigned char* wl = C.ws + WS_W + (size_t)l * LW_BYTES;
#if WIN_FP8 == 1
            pg8::DenseOrder S; S.init(T, NPROJ, DM / 2, DM / 2, wl + LW_IN, C.G, C.bid);
            pg8::EpiBf16S E{WSP(bf16_t, WS_PROJ), NPROJ, 1.f / W1_SCALE};
            pg8::gemm_phase<pg8::EpiBf16S, pg8::DenseOrder, true>(C.ldsl, C.tid, (const char*)(C.ws + WS_H8), DM / 2, S, E);
            if (NREP(2) > 1) { SECTION(); unsigned char* wl3 = C.ws + WS_W + (size_t)l * LW_BYTES; pg8::DenseOrder S3; S3.init(T, NPROJ, DM / 2, DM / 2, wl3 + LW_IN, C.G, C.bid);
                pg8::EpiBf16S E3{WSP(bf16_t, WS_PROJ), NPROJ, 1.f / W1_SCALE}; pg8::gemm_phase<pg8::EpiBf16S, pg8::DenseOrder, true>(C.ldsl, C.tid, (const char*)(C.ws + WS_H8), DM / 2, S3, E3); }
#elif WIN_FP8 == 2
            { pg8::DenseOrder S; S.init(T, NPROJ - WIN_NB * 256, DM / 2, DM / 2, wl + LW_IN, C.G, C.bid); S.pn_cut = WIN_B0; S.pn_add = WIN_NB;
              pg8::EpiBf16S E{WSP(bf16_t, WS_PROJ), NPROJ, 1.f / W1_SCALE};
              pg8::gemm_phase<pg8::EpiBf16S, pg8::DenseOrder, true>(C.ldsl, C.tid, (const char*)(C.ws + WS_H8), DM / 2, S, E); }
            { SECTION(); unsigned char* wl2 = C.ws + WS_W + (size_t)l * LW_BYTES;
              pg8::DenseOrder S; S.init(T, WIN_NB * 256, DM, DM, wl2 + LW_IN + (size_t)NPROJ * DM, C.G, C.bid); S.pn_off = WIN_B0; S.pn_boff = WIN_B0;
              pg8::EpiBf16S E{WSP(bf16_t, WS_PROJ), NPROJ, 1.f};
              pg8::gemm_phase(C.ldsl, C.tid, (const char*)WSP(bf16_t, WS_H), DM, S, E); }
#else
            pg8::DenseOrder S; S.init(T, NPROJ, DM, DM, wl + LW_IN, C.G, C.bid);
            pg8::EpiBf16S E{WSP(bf16_t, WS_PROJ), NPROJ, 1.f};
            pg8::gemm_phase(C.ldsl, C.tid, (const char*)WSP(bf16_t, WS_H), DM, S, E);
#endif
#ifndef NOFILL_A
            FILL();
#endif
            SEAM(pb + 0);
        }
        if (EN(3) && IN(pb + 1)) { SECTION(); phase_postproj(C, l); SEAM(pb + 1); }
        if (EN(4) && IN(pb + 2)) { for (int rp = 0; rp < NREP(4); ++rp) {
            { SECTION(); unsigned char* wl = C.ws + WS_W + (size_t)l * LW_BYTES;
#if UQ_FP8
              pg8::DenseOrder S; S.init(T, 1536, 256, 256, wl + LW_UQ, C.G, C.bid); pg8::EpiBf16S E{WSP(bf16_t, WS_Q), 1536, 1.f / W1_SCALE};
              pg8::gemm_phase<pg8::EpiBf16S, pg8::DenseOrder, true>(C.ldsl, C.tid, (const char*)(C.ws + WS_CQ8), 256, S, E); }
#else
              pg8::DenseOrder S; S.init(T, 1536, 512, NPROJ, wl + LW_UQ, C.G, C.bid); pg8::EpiBf16S E{WSP(bf16_t, WS_Q), 1536, 1.f};
              pg8::gemm_phase(C.ldsl, C.tid, (const char*)(WSP(bf16_t, WS_PROJ) + O_CQ), 512, S, E); }
#endif
#ifdef PROBE_Q3
            { SECTION(); unsigned char* wl = C.ws + WS_W + (size_t)l * LW_BYTES;
#if UQ_FP8
              pg8::DenseOrder S; S.init(T, 1536, 256, 256, wl + LW_UQ, C.G, C.bid); pg8::EpiBf16S E{WSP(bf16_t, WS_Q), 1536, 1.f / W1_SCALE};
              pg8::gemm_phase<pg8::EpiBf16S, pg8::DenseOrder, true>(C.ldsl, C.tid, (const char*)(C.ws + WS_CQ8), 256, S, E); }
#else
              pg8::DenseOrder S; S.init(T, 1536, 512, NPROJ, wl + LW_UQ, C.G, C.bid); pg8::EpiBf16S E{WSP(bf16_t, WS_Q), 1536, 1.f};
              pg8::gemm_phase(C.ldsl, C.tid, (const char*)(WSP(bf16_t, WS_PROJ) + O_CQ), 512, S, E); }
#endif
            { SECTION(); unsigned char* wl = C.ws + WS_W + (size_t)l * LW_BYTES;
#if UQ_FP8
              pg8::DenseOrder S; S.init(T, 1536, 256, 256, wl + LW_UQ, C.G, C.bid); pg8::EpiBf16S E{WSP(bf16_t, WS_Q), 1536, 1.f / W1_SCALE};
              pg8::gemm_phase<pg8::EpiBf16S, pg8::DenseOrder, true>(C.ldsl, C.tid, (const char*)(C.ws + WS_CQ8), 256, S, E); }
#else
              pg8::DenseOrder S; S.init(T, 1536, 512, NPROJ, wl + LW_UQ, C.G, C.bid); pg8::EpiBf16S E{WSP(bf16_t, WS_Q), 1536, 1.f};
              pg8::gemm_phase(C.ldsl, C.tid, (const char*)(WSP(bf16_t, WS_PROJ) + O_CQ), 512, S, E); }
#endif
#endif
#ifndef NO_GEMMKV
            { SECTION(); unsigned char* wl = C.ws + WS_W + (size_t)l * LW_BYTES;
#if UKV_FP8
              pg8::DenseOrder S; S.init(T, 2048, 128, 128, wl + LW_UKV, C.G, C.bid); pg8::EpiBf16S E{WSP(bf16_t, WS_KV), 2048, 1.f / W1_SCALE};
              pg8::gemm_phase<pg8::EpiBf16S, pg8::DenseOrder, true>(C.ldsl, C.tid, (const char*)(C.ws + WS_CKV8), 128, S, E); }
#else
              pg8::DenseOrder S; S.init(T, 2048, 256, NPROJ, wl + LW_UKV, C.G, C.bid); pg8::EpiBf16S E{WSP(bf16_t, WS_KV), 2048, 1.f};
              pg8::gemm_phase(C.ldsl, C.tid, (const char*)(WSP(bf16_t, WS_PROJ) + O_CKV), 256, S, E); }
#endif
#endif
#ifdef PROBE_KV3
            { SECTION(); unsigned char* wl = C.ws + WS_W + (size_t)l * LW_BYTES;
#if UKV_FP8
              pg8::DenseOrder S; S.init(T, 2048, 128, 128, wl + LW_UKV, C.G, C.bid); pg8::EpiBf16S E{WSP(bf16_t, WS_KV), 2048, 1.f / W1_SCALE};
              pg8::gemm_phase<pg8::EpiBf16S, pg8::DenseOrder, true>(C.ldsl, C.tid, (const char*)(C.ws + WS_CKV8), 128, S, E); }
#else
              pg8::DenseOrder S; S.init(T, 2048, 256, NPROJ, wl + LW_UKV, C.G, C.bid); pg8::EpiBf16S E{WSP(bf16_t, WS_KV), 2048, 1.f};
              pg8::gemm_phase(C.ldsl, C.tid, (const char*)(WSP(bf16_t, WS_PROJ) + O_CKV), 256, S, E); }
#endif
            { SECTION(); unsigned char* wl = C.ws + WS_W + (size_t)l * LW_BYTES;
#if UKV_FP8
              pg8::DenseOrder S; S.init(T, 2048, 128, 128, wl + LW_UKV, C.G, C.bid); pg8::EpiBf16S E{WSP(bf16_t, WS_KV), 2048, 1.f / W1_SCALE};
              pg8::gemm_phase<pg8::EpiBf16S, pg8::DenseOrder, true>(C.ldsl, C.tid, (const char*)(C.ws + WS_CKV8), 128, S, E); }
#else
              pg8::DenseOrder S; S.init(T, 2048, 256, NPROJ, wl + LW_UKV, C.G, C.bid); pg8::EpiBf16S E{WSP(bf16_t, WS_KV), 2048, 1.f};
              pg8::gemm_phase(C.ldsl, C.tid, (const char*)(WSP(bf16_t, WS_PROJ) + O_CKV), 256, S, E); }
#endif
#endif
#ifndef NO_INDEXER
            for (int r2 = 0; r2 < NREP(15); ++r2) { SECTION(); phase_indexer(C); }
#endif
            }
            FILL();
            SEAM(pb + 2);
        }
        if (EN(5) && IN(pb + 3)) { for (int rp = 0; rp < NREP(5); ++rp) {
#if QUOTA_R > 0
            { SECTION(); if (C.bid % 3 == 0) cvt_quota(C, QUOTA_R); }
#endif
#ifndef NO_SELECT
            for (int r2 = 0; r2 < NREP(12); ++r2) { SECTION(); phase_select(C); }
#endif
#ifndef NO_MLA
            for (int r2 = 0; r2 < NREP(13); ++r2) { SECTION(); phase_attn_mla(C, l, C.vcu); }
#endif
#if QUOTA_R > 0
            { SECTION(); if (C.bid % 3 == 1) cvt_quota(C, QUOTA_R); }
#endif
#ifndef NO_SB
            for (int r2 = 0; r2 < NREP(14); ++r2) { SECTION(); phase_attn_sb(C, l, C.vcu); }
#endif
            }
            FILL();
            SEAM(pb + 3); }
        if (EN(6) && IN(pb + 4)) { for (int rp = 0; rp < NREP(6); ++rp) { SECTION(); phase_attn_dsa(C, l, C.vcu); } FILL(); SEAM(pb + 4); }
        if (EN(7) && IN(pb + 5)) {
            SECTION(); unsigned char* wl = C.ws + WS_W + (size_t)l * LW_BYTES;
            const float* gate = WSP(const float, WS_MOD) + (size_t)l * NB * 6 * DM + 2 * DM;
#if WO_FP8
            pg8::DenseOrder S; S.init(T, DM, DM / 2, DM / 2, wl + LW_O, C.G, C.bid);
            if (l == 0) { pg8::EpiResidT<false> E{C.ap->in[I_X], WSP(bf16_t, WS_X1), gate, 1.f / W1_SCALE}; pg8::gemm_phase<pg8::EpiResidT<false>, pg8::DenseOrder, true>(C.ldsl, C.tid, (const char*)WSP(bf16_t, WS_O), DM / 2, S, E); }
            else { pg8::EpiResidT<true> E{WSP(const bf16_t, WS_X2), WSP(bf16_t, WS_X1), gate, 1.f / W1_SCALE}; pg8::gemm_phase<pg8::EpiResidT<true>, pg8::DenseOrder, true>(C.ldsl, C.tid, (const char*)WSP(bf16_t, WS_O), DM / 2, S, E); }
            if (NREP(7) > 1) { SECTION(); unsigned char* wl3 = C.ws + WS_W + (size_t)l * LW_BYTES; const float* gate3 = WSP(const float, WS_MOD) + (size_t)l * NB * 6 * DM + 2 * DM;
                pg8::DenseOrder S3; S3.init(T, DM, DM / 2, DM / 2, wl3 + LW_O, C.G, C.bid);
                pg8::EpiResidT<true> E3{WSP(const bf16_t, WS_X2), WSP(bf16_t, WS_X1), gate3, 1.f / W1_SCALE}; if (l == 1) pg8::gemm_phase<pg8::EpiResidT<true>, pg8::DenseOrder, true>(C.ldsl, C.tid, (const char*)WSP(bf16_t, WS_O), DM / 2, S3, E3); }
#else
            pg8::DenseOrder S; S.init(T, DM, DM, DM, wl + LW_O, C.G, C.bid);
            if (l == 0) { pg8::EpiResidT<false> E{C.ap->in[I_X], WSP(bf16_t, WS_X1), gate, 1.f}; pg8::gemm_phase(C.ldsl, C.tid, (const char*)WSP(bf16_t, WS_O), DM, S, E); }
            else { pg8::EpiResidT<true> E{WSP(const bf16_t, WS_X2), WSP(bf16_t, WS_X1), gate, 1.f}; pg8::gemm_phase(C.ldsl, C.tid, (const char*)WSP(bf16_t, WS_O), DM, S, E); }
#endif
            SEAM(pb + 5);
        }
        if (EN(8) && IN(pb + 6)) { if (NREP(8) > 1) { SECTION(); phase_router(C, l, WSP(const bf16_t, WS_X1), false); } { SECTION(); phase_router(C, l, WSP(const bf16_t, WS_X1)); } { SECTION(); cvt_drain(C, l); } SEAM(pb + 6); }
        if (EN(9) && IN(pb + 7)) { for (int rp = 0; rp < NREP(9); ++rp) {
            { SECTION(); moe_tables(C, l); unsigned char* wl = C.ws + WS_W + (size_t)l * LW_BYTES;
              pg8::GroupOrder<true> S; S.init((const LAS int*)(C.ldsl + LDS_TAB), (const LAS int*)(C.ldsl + LDS_TAB) + 64, 4, DM / 2, DM / 2, wl + LW_1, (size_t)1024 * DM, WSP(const int, WS_ST), C.G, C.bid);
              pg8::EpiSwiglu8 E{WSP(bf16_t, WS_H1), 512, 1.f / W1_SCALE};
              pg8::gemm_phase<pg8::EpiSwiglu8, pg8::GroupOrder<true>, true>(C.ldsl, C.tid, (const char*)(C.ws + WS_H8), DM / 2, S, E); }
            { SECTION(); unsigned char* wl = C.ws + WS_W + (size_t)l * LW_BYTES;
#if SH_FP8
              pg8::DenseOrder S; S.init(T, 1024, DM / 2, DM / 2, wl + LW_S1, C.G, C.bid); pg8::EpiSwiglu8 E{WSP(bf16_t, WS_HS), 512, 1.f / W1_SCALE};
              pg8::gemm_phase<pg8::EpiSwiglu8, pg8::DenseOrder, true>(C.ldsl, C.tid, (const char*)(C.ws + WS_H8), DM / 2, S, E); }
#else
              pg8::DenseOrder S; S.init(T, 1024, DM, DM, wl + LW_S1, C.G, C.bid); pg8::EpiSwiglu E{WSP(bf16_t, WS_HS), 512, 1.f};
              pg8::gemm_phase(C.ldsl, C.tid, (const char*)WSP(bf16_t, WS_H), DM, S, E); }
#endif
            }
#ifndef NOFILL_B
            if (l == 0) FILL();
#endif
            SEAM(pb + 7);
        }
        if (EN(10) && IN(pb + 8)) { for (int rp = 0; rp < NREP(10); ++rp) {
            { SECTION(); if (hi - lo <= 1) moe_tables(C, l);        unsigned char* wl = C.ws + WS_W + (size_t)l * LW_BYTES;
              pg8::GroupOrder<false> S; S.init((const LAS int*)(C.ldsl + LDS_TAB), (const LAS int*)(C.ldsl + LDS_TAB) + 64, 8, 256, 256, wl + LW_2, (size_t)DM * 512, nullptr, C.G, C.bid);
              pg8::EpiFp8S E{C.ws + WS_Y, DM, Y_SCALE / W2_SCALE};
              pg8::gemm_phase<pg8::EpiFp8S, pg8::GroupOrder<false>, true>(C.ldsl, C.tid, (const char*)WSP(bf16_t, WS_H1), 256, S, E); }
#ifdef PROBE_G2X
            { SECTION(); unsigned char* wl = C.ws + WS_W + (size_t)l * LW_BYTES;
              pg8::GroupOrder<false> S; S.init((const LAS int*)(C.ldsl + LDS_TAB), (const LAS int*)(C.ldsl + LDS_TAB) + 64, 8, 256, 256, wl + LW_2, (size_t)DM * 512, nullptr, C.G, C.bid);
              pg8::EpiFp8S E{C.ws + WS_Y, DM, Y_SCALE / W2_SCALE};
              pg8::gemm_phase<pg8::EpiFp8S, pg8::GroupOrder<false>, true>(C.ldsl, C.tid, (const char*)WSP(bf16_t, WS_H1), 256, S, E); }
#endif
            { SECTION(); unsigned char* wl = C.ws + WS_W + (size_t)l * LW_BYTES;
#if SH_FP8
              pg8::DenseOrder S; S.init(T, DM, 256, 256, wl + LW_S2, C.G, C.bid); pg8::EpiFp8S E{C.ws + WS_YS, DM, Y_SCALE / W2_SCALE};
              pg8::gemm_phase<pg8::EpiFp8S, pg8::DenseOrder, true>(C.ldsl, C.tid, (const char*)WSP(bf16_t, WS_HS), 256, S, E); }
#else
              pg8::DenseOrder S; S.init(T, DM, 512, 512, wl + LW_S2, C.G, C.bid); pg8::EpiBf16S E{WSP(bf16_t, WS_YS), DM, 1.f};
              pg8::gemm_phase(C.ldsl, C.tid, (const char*)WSP(bf16_t, WS_HS), 512, S, E); }
#endif
            }
#ifndef NOFILL_B
            if (l == 0) FILL();
#endif
            SEAM(pb + 8);
        }
        if (EN(11) && IN(pb + 9)) {
            for (int rp = 0; rp < NREP(11); ++rp) { SECTION();
            if (l == 0) phase_combine<0>(C, l, WSP(const bf16_t, WS_X1), WSP(bf16_t, WS_X2)); else phase_combine<1>(C, l, WSP(const bf16_t, WS_X1), WSP(bf16_t, WS_X2)); }
#ifdef PROBE_CMB3
            { SECTION(); if (l == 0) phase_combine<0>(C, l, WSP(const bf16_t, WS_X1), WSP(bf16_t, WS_X2)); else phase_combine<1>(C, l, WSP(const bf16_t, WS_X1), WSP(bf16_t, WS_X2)); }
            { SECTION(); if (l == 0) phase_combine<0>(C, l, WSP(const bf16_t, WS_X1), WSP(bf16_t, WS_X2)); else phase_combine<1>(C, l, WSP(const bf16_t, WS_X1), WSP(bf16_t, WS_X2)); }
#endif
            SEAM(pb + 9);
        }
    }
#undef IN
#undef SEAM
}

#ifndef MK_FUSED
#define MK_FUSED 0
#endif
extern "C" void kernel_launch(void* const* d_in, const int* in_sizes, int n_in, void* d_out, int out_size, void* d_ws, size_t ws_size, hipStream_t stream) {
    static int grid = 0;
    if (grid == 0) {
        if (n_in != 23 || out_size != T * DM || ws_size < WS_END) { fprintf(stderr, "kernel_launch: unexpected shapes (n_in %d, out %d, ws %zu < %zu)\n", n_in, out_size, ws_size, (size_t)WS_END); grid = -1; return; }
        int dev = 0, cus = 0;
        if (hipGetDevice(&dev) != hipSuccess || hipDeviceGetAttribute(&cus, hipDeviceAttributeMultiprocessorCount, dev) != hipSuccess) { grid = -1; return; }
#ifndef NO_ATTR
        if (hipFuncSetAttribute((const void*)fwd, hipFuncAttributeMaxDynamicSharedMemorySize, LDS_BYTES) != hipSuccess) { fprintf(stderr, "kernel_launch: hipFuncSetAttribute failed\n"); grid = -1; return; }
#endif
#ifndef NO_OCC
        int per_cu = 0;
        if (hipOccupancyMaxActiveBlocksPerMultiprocessor(&per_cu, (const void*)fwd, NTHR, LDS_BYTES) != hipSuccess || per_cu < 1) fprintf(stderr, "kernel_launch: occupancy query says %d\n", per_cu);
        (void)hipGetLastError();
#endif
        grid = cus;
    }
    if (grid < 0) return;
    (void)hipMemsetAsync((char*)d_ws + WS_CTL, 0, CTL_BYTES, stream);
    Args a{};
    for (int i = 0; i < 23; ++i) a.in[i] = (const float*)d_in[i];
    a.out = (float*)d_out; a.ws = (unsigned char*)d_ws;
#if MK_FUSED
    a.ph_lo = 0; a.ph_hi = NPHASE;
    hipLaunchKernelGGL(fwd, dim3(grid), dim3(NTHR), LDS_BYTES, stream, a);
#else
#ifndef MAXPH
#define MAXPH NPHASE
#endif
    for (int p = 0; p < MAXPH; ++p) { a.ph_lo = p; a.ph_hi = p + 1; hipLaunchKernelGGL(fwd, dim3(grid), dim3(NTHR), LDS_BYTES, stream, a); }
#endif
}
```
